# Optimizing an MI355X kernel written in HIP

```python
import math
import jax, jax.numpy as jnp
from jax import lax
import numpy as np

D_MODEL = 1024
BATCH = 32
SEQ = 2048
DEPTH = 2

N_HEADS = 8
Q_LORA = 256
KV_LORA = 128
QK_NOPE = 64
QK_ROPE = 32
V_HEAD = 64
ROPE_THETA = 10000.0
Q_BLOCK = 128
D_HY = 512
SHORT_CONV = 3
FILTER_EMB = 33
FILTER_HIDDEN = 64
FAST_DECAY_PCT = 0.3
SLOW_DECAY_PCT = 1.5
DECAY_TARGET = 1e-2
MOD_SHIFT = 0.0
D_FF = -(-8 * D_MODEL // (3 * 256)) * 256
EPS = 1e-6
IN_SPLITS = (Q_LORA, Q_LORA + KV_LORA, Q_LORA + KV_LORA + QK_ROPE, Q_LORA + KV_LORA + QK_ROPE + 3 * D_HY)
IN_COLS = IN_SPLITS[-1] + 2 * D_MODEL

kernel_name = 'hybrid_mla_hyena_gated_encoder'


def rms_norm(x, g):
    xf = x.astype(jnp.float32)
    y = xf * lax.rsqrt(jnp.mean(xf * xf, axis=-1, keepdims=True) + EPS)
    return (y * g.astype(jnp.float32)).astype(x.dtype)


def rope_tables(positions):
    inv = 1.0 / (ROPE_THETA ** (jnp.arange(0, QK_ROPE, 2, dtype=jnp.float32) / QK_ROPE))
    ang = positions.astype(jnp.float32)[:, None] * inv[None, :]
    return jnp.cos(ang), jnp.sin(ang)


def apply_rope(x, cos, sin):
    xf = x.astype(jnp.float32).reshape(x.shape[:-1] + (QK_ROPE // 2, 2))
    bshape = (1, cos.shape[0]) + (1,) * (x.ndim - 3) + (cos.shape[1],)
    c = cos.reshape(bshape)
    s = sin.reshape(bshape)
    x0, x1 = xf[..., 0], xf[..., 1]
    return jnp.stack([x0 * c - x1 * s, x0 * s + x1 * c], axis=-1).reshape(x.shape).astype(x.dtype)


def mla_branch(q_lat, kv_lat, k_pe, q_norm_g, w_q_up, kv_norm_g, w_kv_up, w_attn_proj, cos, sin):
    b, s, _ = q_lat.shape
    q = (rms_norm(q_lat, q_norm_g) @ w_q_up).reshape(b, s, N_HEADS, QK_NOPE + QK_ROPE)
    q_nope = q[..., :QK_NOPE]
    q_pe = apply_rope(q[..., QK_NOPE:], cos, sin)
    kv = (rms_norm(kv_lat, kv_norm_g) @ w_kv_up).reshape(b, s, N_HEADS, QK_NOPE + V_HEAD)
    k_nope, v = kv[..., :QK_NOPE], kv[..., QK_NOPE:]
    k_pe = apply_rope(k_pe, cos, sin)
    scale = (QK_NOPE + QK_ROPE) ** -0.5
    nb = s // Q_BLOCK
    qn_blocks = jnp.moveaxis(q_nope.reshape(b, nb, Q_BLOCK, N_HEADS, QK_NOPE), 1, 0)
    qp_blocks = jnp.moveaxis(q_pe.reshape(b, nb, Q_BLOCK, N_HEADS, QK_ROPE), 1, 0)

    def attend(blk):
        qn, qp = blk
        logits = (jnp.einsum('bqhd,bkhd->bhqk', qn, k_nope, preferred_element_type=jnp.float32)
                  + jnp.einsum('bqhr,bkr->bhqk', qp, k_pe, preferred_element_type=jnp.float32)) * scale
        probs = jax.nn.softmax(logits, axis=-1).astype(v.dtype)
        return jnp.einsum('bhqk,bkhd->bqhd', probs, v)

    o = lax.map(attend, (qn_blocks, qp_blocks))
    o = jnp.moveaxis(o, 0, 1).reshape(b, s, N_HEADS * V_HEAD)
    return o @ w_attn_proj


def hyena_filters(length, w1, b1, f1, w2, b2, f2, w3, b3, f3, w4):
    f32 = jnp.float32
    t = jnp.linspace(0.0, 1.0, length, dtype=f32)[:, None]
    bands = (FILTER_EMB - 1) // 2
    freqs = jnp.linspace(1e-4, bands - 1, bands, dtype=f32)[None, :]
    w = 2.0 * math.pi * jnp.arange(length, dtype=f32)[:, None] / length
    z = jnp.concatenate([t, jnp.cos(freqs * w), -jnp.sin(freqs * w)], axis=-1)
    h = jnp.sin(f1.astype(f32) * (z @ w1.astype(f32) + b1.astype(f32)))
    h = jnp.sin(f2.astype(f32) * (h @ w2.astype(f32) + b2.astype(f32)))
    h = jnp.sin(f3.astype(f32) * (h @ w3.astype(f32) + b3.astype(f32)))
    h = h @ w4.astype(f32)
    deltas = jnp.abs(jnp.linspace(math.log(DECAY_TARGET) / FAST_DECAY_PCT,
                                  math.log(DECAY_TARGET) / SLOW_DECAY_PCT, D_HY, dtype=f32))
    decay = jnp.exp(-t * jnp.tile(deltas, 2)[None, :])
    return h * (decay + MOD_SHIFT)


def hyena_branch(u, conv_w, conv_b, w1, b1, f1, w2, b2, f2, w3, b3, f3, w4, hy_skip, w_hy_proj):
    b, length, _ = u.shape
    up = jnp.pad(u, ((0, 0), (1, 1), (0, 0)))
    uc = up[:, :-2] * conv_w[0] + up[:, 1:-1] * conv_w[1] + up[:, 2:] * conv_w[2] + conv_b
    x0, x1, v = jnp.split(uc, 3, axis=-1)
    filt = hyena_filters(length, w1, b1, f1, w2, b2, f2, w3, b3, f3, w4)
    taps = jnp.concatenate([filt[:, :D_HY], jnp.zeros((1, D_HY), jnp.float32),
                            jnp.flip(filt[1:, D_HY:], axis=0)], axis=0)
    z = (v * x1).astype(jnp.float32)
    spec = jnp.fft.rfft(z, n=2 * length, axis=1) * jnp.fft.rfft(taps, axis=0)[None]
    y = jnp.fft.irfft(spec, n=2 * length, axis=1)[:, :length] + z * hy_skip.astype(jnp.float32)
    y = (y * x0.astype(jnp.float32)).astype(u.dtype)
    return y @ w_hy_proj


def setup_inputs(seed: int = 0) -> dict:
    key = jax.random.key(seed)
    ks = iter(jax.random.split(key, 40))

    def nrm(shape, scale):
        return jax.random.normal(next(ks), shape, jnp.float32) * scale

    def gain(shape):
        return 1.0 + nrm(shape, 0.02)

    L = DEPTH
    x = nrm((BATCH, SEQ, D_MODEL), 1.0)
    positions = jnp.arange(SEQ, dtype=jnp.int32)
    mix_norm_g = gain((L, D_MODEL))
    w_in = nrm((L, D_MODEL, IN_COLS), D_MODEL ** -0.5)
    q_norm_g = gain((L, Q_LORA))
    w_q_up = nrm((L, Q_LORA, N_HEADS * (QK_NOPE + QK_ROPE)), Q_LORA ** -0.5)
    kv_norm_g = gain((L, KV_LORA))
    w_kv_up = nrm((L, KV_LORA, N_HEADS * (QK_NOPE + V_HEAD)), KV_LORA ** -0.5)
    w_attn_proj = nrm((L, N_HEADS * V_HEAD, D_MODEL), (N_HEADS * V_HEAD) ** -0.5)
    hy_conv_w = nrm((L, SHORT_CONV, 3 * D_HY), SHORT_CONV ** -0.5)
    hy_conv_b = nrm((L, 3 * D_HY), 0.02)
    filt_w1 = nrm((L, FILTER_EMB, FILTER_HIDDEN), FILTER_EMB ** -0.5)
    filt_b1 = nrm((L, FILTER_HIDDEN), 0.02)
    filt_f1 = gain((L, FILTER_HIDDEN))
    filt_w2 = nrm((L, FILTER_HIDDEN, FILTER_HIDDEN), FILTER_HIDDEN ** -0.5)
    filt_b2 = nrm((L, FILTER_HIDDEN), 0.02)
    filt_f2 = gain((L, FILTER_HIDDEN))
    filt_w3 = nrm((L, FILTER_HIDDEN, FILTER_HIDDEN), FILTER_HIDDEN ** -0.5)
    filt_b3 = nrm((L, FILTER_HIDDEN), 0.02)
    filt_f3 = gain((L, FILTER_HIDDEN))
    filt_w4 = nrm((L, FILTER_HIDDEN, 2 * D_HY), 0.1 * FILTER_HIDDEN ** -0.5)
    hy_skip = nrm((L, D_HY), 0.1)
    w_hy_proj = nrm((L, D_HY, D_MODEL), D_HY ** -0.5)
    w_out = nrm((L, D_MODEL, D_MODEL), D_MODEL ** -0.5)
    ffn_norm_g = gain((L, D_MODEL))
    w_gate = nrm((L, D_MODEL, D_FF), D_MODEL ** -0.5)
    w_up = nrm((L, D_MODEL, D_FF), D_MODEL ** -0.5)
    w_down = nrm((L, D_FF, D_MODEL), D_FF ** -0.5)
    final_norm_g = gain((D_MODEL,))
    return {'x': x, 'positions': positions, 'mix_norm_g': mix_norm_g, 'w_in': w_in,
            'q_norm_g': q_norm_g, 'w_q_up': w_q_up, 'kv_norm_g': kv_norm_g, 'w_kv_up': w_kv_up,
            'w_attn_proj': w_attn_proj, 'hy_conv_w': hy_conv_w, 'hy_conv_b': hy_conv_b,
            'filt_w1': filt_w1, 'filt_b1': filt_b1, 'filt_f1': filt_f1,
            'filt_w2': filt_w2, 'filt_b2': filt_b2, 'filt_f2': filt_f2,
            'filt_w3': filt_w3, 'filt_b3': filt_b3, 'filt_f3': filt_f3, 'filt_w4': filt_w4,
            'hy_skip': hy_skip, 'w_hy_proj': w_hy_proj, 'w_out': w_out,
            'ffn_norm_g': ffn_norm_g, 'w_gate': w_gate, 'w_up': w_up, 'w_down': w_down,
            'final_norm_g': final_norm_g}


def reference(x, positions, mix_norm_g, w_in, q_norm_g, w_q_up, kv_norm_g, w_kv_up,
              w_attn_proj, hy_conv_w, hy_conv_b, filt_w1, filt_b1, filt_f1,
              filt_w2, filt_b2, filt_f2, filt_w3, filt_b3, filt_f3, filt_w4,
              hy_skip, w_hy_proj, w_out, ffn_norm_g, w_gate, w_up, w_down, final_norm_g):
    cos, sin = rope_tables(positions)
    for i in range(DEPTH):
        h = rms_norm(x, mix_norm_g[i])
        proj = h @ w_in[i]
        q_lat, kv_lat, k_pe, hy_in, gate_logits = jnp.split(proj, IN_SPLITS, axis=-1)
        y_attn = mla_branch(q_lat, kv_lat, k_pe, q_norm_g[i], w_q_up[i], kv_norm_g[i], w_kv_up[i],
                            w_attn_proj[i], cos, sin)
        y_hy = hyena_branch(hy_in, hy_conv_w[i], hy_conv_b[i], filt_w1[i], filt_b1[i], filt_f1[i],
                            filt_w2[i], filt_b2[i], filt_f2[i], filt_w3[i], filt_b3[i], filt_f3[i],
                            filt_w4[i], hy_skip[i], w_hy_proj[i])
        gates = jax.nn.sigmoid(gate_logits.astype(jnp.float32))
        merged = (gates[..., :D_MODEL] * y_attn.astype(jnp.float32)
                  + gates[..., D_MODEL:] * y_hy.astype(jnp.float32)).astype(x.dtype)
        x = x + merged @ w_out[i]
        h = rms_norm(x, ffn_norm_g[i])
        x = x + (jax.nn.silu(h @ w_gate[i]) * (h @ w_up[i])) @ w_down[i]
    return rms_norm(x, final_norm_g)
```

```cpp
#include <hip/hip_runtime.h>
#include <hip/hip_cooperative_groups.h>
#include <cstdio>
#include <cstdint>
namespace cg = cooperative_groups;

#ifndef FAST_GEMM
#define FAST_GEMM 1
#endif
#ifndef FAST_ATTN
#define FAST_ATTN 1
#endif
#ifndef FAST_HYENA
#define FAST_HYENA 1
#endif

#ifndef DBL_PHASE
#define DBL_PHASE 0
#endif
#define LAS __attribute__((address_space(3)))
typedef unsigned short bf16_t;
typedef short bf16x8 __attribute__((ext_vector_type(8)));
typedef short s16x4 __attribute__((ext_vector_type(4)));
typedef float f32x4 __attribute__((ext_vector_type(4)));
typedef float f32x2 __attribute__((ext_vector_type(2)));
typedef float f32x16 __attribute__((ext_vector_type(16)));
typedef unsigned u32x4 __attribute__((ext_vector_type(4)));
typedef unsigned u32x2 __attribute__((ext_vector_type(2)));

constexpr int DM = 1024, NB = 32, SEQ = 2048, MTOK = NB * SEQ, NH = 8, QL = 256, KVL = 128, NOPE = 64, ROPE = 32, VH = 64, DHY = 512, DFF = 2816, INC = 4000;
constexpr int DQK = NOPE + ROPE;
constexpr float EPS = 1e-6f;
namespace att { constexpr float QSCALE = 0.10206207261596575f * 1.4426950408889634f; }
constexpr int NTHR = 512, NWAVE = 8;
constexpr int LDS_BYTES = 136192;
constexpr int LDS_CTL = 131072, LDS_TAB = 131072 + 1024;

constexpr size_t MiB = 1u << 20;
constexpr size_t WS_BAR = 0;
constexpr size_t WS_ROPE = 1 * MiB;
constexpr size_t WS_SSQ = 952 * MiB;
constexpr size_t WS_TAPS = 4 * MiB;
constexpr size_t WS_W = 12 * MiB, W_LAYER = 30 * MiB;
constexpr size_t WO_IN = 0, WO_Q = 8 * MiB, WO_KV = WO_Q + 384 * 1024, WO_A = WO_KV + 512 * 1024, WO_H = WO_A + 1 * MiB, WO_O = WO_H + 1 * MiB,
                 WO_GU = WO_O + 2 * MiB, WO_D = WO_GU + 11 * MiB;
constexpr size_t WS_H = 72 * MiB;
constexpr size_t WS_ZT = WS_H, WS_X0C = WS_H + 64 * MiB;
constexpr size_t WS_LAT = 200 * MiB;
constexpr size_t WS_HYIN = 264 * MiB;
constexpr size_t WS_O = WS_HYIN, WS_YT = WS_HYIN + 128 * MiB;
constexpr size_t WS_GATES = 456 * MiB;
constexpr size_t WS_Q = 712 * MiB, WS_KV = 808 * MiB, WS_KPE = 936 * MiB;
constexpr size_t WS_MERGED = WS_Q;
constexpr size_t WS_ACT = WS_LAT;
constexpr size_t WS_WM = 944 * MiB, WM_LAYER = 4 * MiB;
constexpr size_t WS_XF = 552 * MiB;
constexpr size_t WS_END = 968 * MiB;

struct Params { const float* in[29]; float* out; unsigned char* ws; };

__device__ __forceinline__ int opaque_tid() { int t = threadIdx.x; asm volatile("" : "+v"(t)); return t; }
__device__ __forceinline__ float bf2f(unsigned v) { return __uint_as_float(v << 16); }
__device__ __forceinline__ unsigned f2bf(float f) { unsigned u = __float_as_uint(f); return (u + 0x7fffu + ((u >> 16) & 1u)) >> 16; }
__device__ __forceinline__ unsigned pk2(float lo, float hi) { return f2bf(lo) | (f2bf(hi) << 16); }
__device__ __forceinline__ unsigned cvt_pk_bf16(float lo, float hi) { unsigned r; asm volatile("v_cvt_pk_bf16_f32 %0, %1, %2" : "=v"(r) : "v"(lo), "v"(hi)); return r; }
__device__ __forceinline__ float fast_sigmoid(float x) { return __builtin_amdgcn_rcpf(1.0f + __expf(-x)); }
__device__ __forceinline__ void unpack8(u32x4 w, float* f) {
    f[0] = __uint_as_float(w.x << 16); f[1] = __uint_as_float(w.x & 0xffff0000u); f[2] = __uint_as_float(w.y << 16); f[3] = __uint_as_float(w.y & 0xffff0000u);
    f[4] = __uint_as_float(w.z << 16); f[5] = __uint_as_float(w.z & 0xffff0000u); f[6] = __uint_as_float(w.w << 16); f[7] = __uint_as_float(w.w & 0xffff0000u);
}
__device__ __forceinline__ u32x4 pack8(const float* f) { u32x4 w; w.x = cvt_pk_bf16(f[0], f[1]); w.y = cvt_pk_bf16(f[2], f[3]); w.z = cvt_pk_bf16(f[4], f[5]); w.w = cvt_pk_bf16(f[6], f[7]); return w; }

namespace pg8 {
#define PG8_LAS __attribute__((address_space(3)))
constexpr int BM = 256, BK = 64, HALF = 128, HTB = HALF * BK * 2  , STAGE_BYTES = 8 * HTB, NXCD = 8, WGM = 8;
__host__ __device__ __forceinline__ int lds_byte(int r, int c) { const int st = (r >> 4) * 2 + (c >> 5), rr = r & 15, cc = c & 31, ob = rr * 64 + cc * 2; return st * 1024 + (ob ^ (((ob >> 9) & 1) << 5)); }
__host__ __device__ __forceinline__ void stage_rc(int b, int& R, int& C) { const int st = b / 1024, sb = b % 1024, swz = sb ^ (((sb >> 9) & 1) << 5); R = (st >> 1) * 16 + swz / 64; C = (st & 1) * 32 + (swz % 64) / 2; }
__host__ __device__ __forceinline__ int perm32(int rho) { const int n = rho >> 4, i = rho & 15; return 8 * (i >> 2) + 4 * n + (i & 3); }

struct Unit { int pm, pn; };
struct Gemm { const bf16_t* A; const bf16_t* Bt; int M, N, K, lda; };

struct StaticOrder {
    int nM, nN, nwg, G, c;
    __host__ __device__ void init(int M, int N, int G_, int c_) { nM = M / BM; nN = N / BM; nwg = nM * nN; G = G_; c = c_; }
    __host__ __device__ bool next(int i, Unit& u) const {
        const long L = (long)i * G + c; if (L >= nwg) return false;
        int wgid = (int)L; { const int q = nwg / NXCD, r = nwg % NXCD, xcd = wgid % NXCD, off = wgid / NXCD; wgid = (xcd < r ? xcd * (q + 1) : r * (q + 1) + (xcd - r) * q) + off; }
        const int nig = WGM * nN, gid = wgid / nig, fm = gid * WGM, gsz = (nM - fm) < WGM ? (nM - fm) : WGM;
        u.pm = fm + ((wgid % nig) % gsz); u.pn = (wgid % nig) / gsz; return true;
    }
    __device__ __forceinline__ void a_ready(const Unit&) const {}
    __device__ __forceinline__ void done(const Unit&) const {}
};

template <class F> struct Epi8 {
    static constexpr bool PERM = true, AFTER_DRAIN = false, HALFSKIP = false; F f;
    __device__ __forceinline__ void operator()(const f32x4 (&acc)[2][2][4][2], const Unit& u, int wr, int wc, int fr, int fq) const {
        float rs[2][4];
#pragma unroll
        for (int ai = 0; ai < 2; ++ai)
#pragma unroll
            for (int m = 0; m < 4; ++m) rs[ai][m] = f.rowscale(u.pm * BM + ai * HALF + wr * 64 + m * 16 + fr);
#pragma unroll
        for (int ai = 0; ai < 2; ++ai) {
#pragma unroll
            for (int m = 0; m < 4; ++m) { const int row = u.pm * BM + ai * HALF + wr * 64 + m * 16 + fr;
#pragma unroll
                for (int bj = 0; bj < 2; ++bj) f(row, u.pn * BM + bj * HALF + wc * 32 + 8 * fq, acc[ai][bj][m][0] * rs[ai][m], acc[ai][bj][m][1] * rs[ai][m]); }
            }
    }
};
template <class F> struct Epi4 {
    static constexpr bool PERM = false, AFTER_DRAIN = false, HALFSKIP = false; F f;
    __device__ __forceinline__ void operator()(const f32x4 (&acc)[2][2][4][2], const Unit& u, int wr, int wc, int fr, int fq) const {
#pragma unroll
        for (int ai = 0; ai < 2; ++ai)
#pragma unroll
            for (int m = 0; m < 4; ++m) { const int row = u.pm * BM + ai * HALF + wr * 64 + m * 16 + fr;
#pragma unroll
                for (int bj = 0; bj < 2; ++bj)
#pragma unroll
                    for (int n = 0; n < 2; ++n) f(row, u.pn * BM + bj * HALF + wc * 32 + 16 * n + 4 * fq, acc[ai][bj][m][n]);
                asm volatile("" ::: "memory"); }
    }
};

template <class Epi, class Sched>
__device__ __forceinline__ void gemm_simple(const Gemm g, const Sched& S, const Epi& E) {
    const int tid = opaque_tid(), wid = tid >> 6, lane = tid & 63, wr = wid >> 2, wc = wid & 3, fr = lane & 15, fq = lane >> 4;
    Unit u;
    for (int i = 0; S.next(i, u); ++i) {
        f32x4 acc[2][2][4][2];
#pragma unroll
        for (int a = 0; a < 2; ++a)
#pragma unroll
            for (int b = 0; b < 2; ++b)
#pragma unroll
                for (int m = 0; m < 4; ++m)
#pragma unroll
                    for (int n = 0; n < 2; ++n) acc[a][b][m][n] = (f32x4){0.f, 0.f, 0.f, 0.f};
        const bf16_t* Ab = g.A + (size_t)(u.pm * BM + wr * 64 + fr) * g.lda + fq * 8;
        const bf16_t* Bb = g.Bt + (size_t)(u.pn * BM + wc * 32) * g.K + fq * 8;
#pragma unroll 1
        for (int k0 = 0; k0 < g.K; k0 += 32) {
            bf16x8 Bf[2][2];
#pragma unroll
            for (int bj = 0; bj < 2; ++bj)
#pragma unroll
                for (int n = 0; n < 2; ++n) { const int rho = 16 * n + fr; const int wrow = bj * HALF + (Epi::PERM ? perm32(rho) : rho);
                    Bf[bj][n] = *(const bf16x8*)(Bb + (size_t)wrow * g.K + k0); }
#pragma unroll
            for (int ai = 0; ai < 2; ++ai)
#pragma unroll
                for (int m = 0; m < 4; ++m) { const bf16x8 Af = *(const bf16x8*)(Ab + (size_t)(ai * HALF + m * 16) * g.lda + k0);
#pragma unroll
                    for (int bj = 0; bj < 2; ++bj)
#pragma unroll
                        for (int n = 0; n < 2; ++n) acc[ai][bj][m][n] = __builtin_amdgcn_mfma_f32_16x16x32_bf16(Bf[bj][n], Af, acc[ai][bj][m][n], 0, 0, 0); }
        }
        E(acc, u, wr, wc, fr, fq);
    }
}

template <class Epi, class Sched, bool ALIGN_EPI = false, bool SP2 = false>
__device__ __forceinline__ void gemm_phase(PG8_LAS unsigned char* lds, const Gemm g, const Sched& S, const Epi& E) {
    const int tid = opaque_tid(), wid = __builtin_amdgcn_readfirstlane(tid >> 6), lane = tid & 63, wr = wid >> 2, wc = wid & 3, fr = lane & 15, fq = lane >> 4;
    int Kop = g.K; asm volatile("" : "+s"(Kop));
    const int K = Kop, nt = K / BK;
    unsigned voffA[2], voffB[2];
#pragma unroll
    for (int i = 0; i < 2; ++i) { int R, C; stage_rc(tid * 16 + i * 8192, R, C); const int Rb = Epi::PERM ? ((R & ~31) + perm32(R & 31)) : R;
        voffA[i] = (unsigned)(R * g.lda + C) * 2u; voffB[i] = (unsigned)(Rb * K + C) * 2u; }
    const size_t kstep = (size_t)(BK * 2);
    const size_t hstepA = (size_t)HALF * g.lda * 2, hstepB = (size_t)HALF * K * 2;
    const size_t tstepA = 2 * hstepA, tstepB = 2 * hstepB;
    const unsigned ldsw = (unsigned)wid * 1024u;
    const int aoff = lds_byte(wr * 64 + fr, fq * 8), boff = lds_byte(wc * 32 + fr, fq * 8);
#define PG8_SA(b, h) (((b) * 2 + (h)) * HTB)
#define PG8_SB(b, h) ((4 + (b) * 2 + (h)) * HTB)
#define PG8_STAGE(bufoff, gbase, voff) do { _Pragma("unroll") for (int _i = 0; _i < 2; ++_i) \
        __builtin_amdgcn_global_load_lds((const unsigned*)((const char*)(gbase) + (voff)[_i]), (PG8_LAS unsigned*)(lds + (bufoff) + ldsw + _i * 8192), 16, 0, 0); } while (0)
#define PG8_LDA(dst, b, h) do { _Pragma("unroll") for (int m = 0; m < 4; ++m) _Pragma("unroll") for (int k = 0; k < 2; ++k) dst[m][k] = *(const PG8_LAS bf16x8*)(lds + PG8_SA(b, h) + aoff + m * 2048 + k * 1024); } while (0)
#define PG8_LDB(dst, b, h) do { _Pragma("unroll") for (int n = 0; n < 2; ++n) _Pragma("unroll") for (int k = 0; k < 2; ++k) dst[n][k] = *(const PG8_LAS bf16x8*)(lds + PG8_SB(b, h) + boff + n * 2048 + k * 1024); } while (0)
#define PG8_MMA(ai, bj, At, Bt) do { __builtin_amdgcn_s_setprio(1); _Pragma("unroll") for (int m = 0; m < 4; ++m) _Pragma("unroll") for (int n = 0; n < 2; ++n) _Pragma("unroll") for (int k = 0; k < 2; ++k) \
        acc[ai][bj][m][n] = __builtin_amdgcn_mfma_f32_16x16x32_bf16(Bt[n][k], At[m][k], acc[ai][bj][m][n], 0, 0, 0); __builtin_amdgcn_s_setprio(0); } while (0)
#define PG8_WAIT_V(n) asm volatile("s_waitcnt vmcnt(" #n ")" ::: "memory")
#define PG8_WAIT_L(n) asm volatile("s_waitcnt lgkmcnt(" #n ")" ::: "memory")
#define PG8_BAR __builtin_amdgcn_s_barrier()
#define PG8_SCHED __builtin_amdgcn_sched_barrier(0)
    Unit cur, nxt; int ui = 0;
    if (!S.next(0, cur)) return;
    f32x4 acc[2][2][4][2];
#pragma unroll
    for (int a = 0; a < 2; ++a)
#pragma unroll
        for (int b = 0; b < 2; ++b)
#pragma unroll
            for (int m = 0; m < 4; ++m)
#pragma unroll
                for (int n = 0; n < 2; ++n) acc[a][b][m][n] = (f32x4){0.f, 0.f, 0.f, 0.f};
    bf16x8 At[4][2], B0[2][2], B1[2][2];
    const char* cA = (const char*)g.A + (size_t)cur.pm * tstepA; const char* cB = (const char*)g.Bt + (size_t)cur.pn * tstepB;
    S.a_ready(cur);
    if constexpr (SP2) {
        PG8_STAGE(PG8_SB(0, 0), cB, voffB); PG8_STAGE(PG8_SB(0, 1), cB + hstepB, voffB); PG8_STAGE(PG8_SA(0, 0), cA, voffA); PG8_STAGE(PG8_SA(0, 1), cA + hstepA, voffA);
        if (wr == 1) PG8_BAR;
        PG8_WAIT_V(2); PG8_BAR;
        PG8_STAGE(PG8_SB(1, 0), cB + kstep, voffB); PG8_STAGE(PG8_SA(1, 0), cA + kstep, voffA); PG8_STAGE(PG8_SB(1, 1), cB + hstepB + kstep, voffB);
        PG8_WAIT_V(6); PG8_BAR;
    } else {
        PG8_STAGE(PG8_SB(0, 0), cB, voffB); PG8_STAGE(PG8_SA(0, 0), cA, voffA); PG8_STAGE(PG8_SB(0, 1), cB + hstepB, voffB); PG8_STAGE(PG8_SA(0, 1), cA + hstepA, voffA);
        if (wr == 1) PG8_BAR;
        PG8_WAIT_V(4); PG8_BAR;
        PG8_STAGE(PG8_SB(1, 0), cB + kstep, voffB); PG8_STAGE(PG8_SA(1, 0), cA + kstep, voffA); PG8_STAGE(PG8_SB(1, 1), cB + hstepB + kstep, voffB);
        PG8_WAIT_V(6); PG8_BAR;
    }
    for (;;) {
        const bool has_next = S.next(ui + 1, nxt);
        const char* nA = has_next ? (const char*)g.A + (size_t)nxt.pm * tstepA : cA; const char* nB = has_next ? (const char*)g.Bt + (size_t)nxt.pn * tstepB : cB;
#define PG8_MM_BOTH(ai) do { PG8_MMA(ai, 0, At, B0); PG8_MMA(ai, 1, At, B1); } while (0)
#define PG8_MM_H0(ai) PG8_MMA(ai, 0, At, B0)
#define PG8_MM_H1(ai) PG8_MMA(ai, 1, At, B1)
#define PG8_SPBLOCK(MM) do { \
            PG8_LDB(B0, 0, 0); PG8_LDB(B1, 0, 1); PG8_SCHED; PG8_LDA(At, 0, 0); PG8_STAGE(PG8_SA(1, 1), a1 + hstepA, voffA); \
            PG8_WAIT_V(8); PG8_WAIT_L(0); PG8_BAR; MM(0); PG8_BAR; PG8_SCHED; \
            PG8_LDA(At, 0, 1); PG8_STAGE(PG8_SB(0, 0), b2, voffB); PG8_STAGE(PG8_SB(0, 1), b2 + hstepB, voffB); PG8_STAGE(PG8_SA(0, 0), a2, voffA); \
            PG8_WAIT_V(8); PG8_WAIT_L(0); PG8_BAR; MM(1); PG8_BAR; PG8_SCHED; \
            PG8_LDB(B0, 1, 0); PG8_LDB(B1, 1, 1); PG8_SCHED; PG8_LDA(At, 1, 0); PG8_STAGE(PG8_SA(0, 1), a2 + hstepA, voffA); \
            PG8_WAIT_V(8); PG8_WAIT_L(0); PG8_BAR; MM(0); PG8_BAR; PG8_SCHED; \
            PG8_LDA(At, 1, 1); PG8_STAGE(PG8_SB(1, 0), b3, voffB); PG8_STAGE(PG8_SB(1, 1), b3 + hstepB, voffB); PG8_STAGE(PG8_SA(1, 0), a3, voffA); \
            PG8_WAIT_V(8); PG8_WAIT_L(0); PG8_BAR; MM(1); PG8_BAR; PG8_SCHED; \
            } while (0)
#define PG8_TBODY(MM) do { \
            const bool last = (t == nt - 2); \
            const char* a1 = cA + (size_t)(t + 1) * kstep; \
            const char* a2 = last ? nA : cA + (size_t)(t + 2) * kstep; const char* b2 = last ? nB : cB + (size_t)(t + 2) * kstep; \
            const char* a3 = a2 + kstep; const char* b3 = b2 + kstep; \
            if (last && has_next) S.a_ready(nxt); \
            PG8_SPBLOCK(MM); } while (0)
        static_assert(SP2, "this copy keeps only the two-super-phase K-loop");
        if constexpr (Epi::HALFSKIP) { int t = 0; for (; t < (nt >> 1); t += 2) PG8_TBODY(PG8_MM_H0); for (; t < nt; t += 2) PG8_TBODY(PG8_MM_H1); }
        else { for (int t = 0; t < nt; t += 2) PG8_TBODY(PG8_MM_BOTH); }
        if constexpr (ALIGN_EPI) { if (wr == 0) PG8_BAR; }
        if constexpr (!Epi::AFTER_DRAIN) { E(acc, cur, wr, wc, fr, fq); S.done(cur); }
        if (!has_next) break;
#pragma unroll
        for (int a = 0; a < 2; ++a)
#pragma unroll
            for (int b = 0; b < 2; ++b)
#pragma unroll
                for (int m = 0; m < 4; ++m)
#pragma unroll
                    for (int n = 0; n < 2; ++n) acc[a][b][m][n] = (f32x4){0.f, 0.f, 0.f, 0.f};
        cur = nxt; cA = nA; cB = nB; ++ui;
        if constexpr (ALIGN_EPI) { if (wr == 1) PG8_BAR; }
    }
    PG8_WAIT_V(0);
    if constexpr (!ALIGN_EPI) { if (wr == 0) PG8_BAR; }
    PG8_BAR;
    if constexpr (Epi::AFTER_DRAIN) { E.fused(acc, cur, wr, wc, fr, fq, lds, wid, lane); S.done(cur); }
#undef PG8_SA
#undef PG8_SB
#undef PG8_STAGE
#undef PG8_LDA
#undef PG8_LDB
#undef PG8_MMA
#undef PG8_SPBLOCK
#undef PG8_TBODY
#undef PG8_MM_BOTH
#undef PG8_MM_H0
#undef PG8_MM_H1
#undef PG8_WAIT_V
#undef PG8_WAIT_L
#undef PG8_BAR
#undef PG8_SCHED
}
}


#define XB_TMO      128
#define XB_XCNT(j)  (256  + 64 * (j))
#define XB_XSUB(j)  (1280 + 64 * (j))
#define XB_XGEN(j)  (2304 + 64 * (j))
#define XB_TOP      3328
#define XB_TOPGEN   3392
#define XCD_BAR_WORDS 3456
#define XB_SPIN_CAP (1u << 18)

__device__ __forceinline__ unsigned xb_ld(unsigned* p)              { return __hip_atomic_load(p, __ATOMIC_RELAXED, __HIP_MEMORY_SCOPE_AGENT); }
__device__ __forceinline__ unsigned xb_add(unsigned* p, unsigned v) { return __hip_atomic_fetch_add(p, v, __ATOMIC_RELAXED, __HIP_MEMORY_SCOPE_AGENT); }
__device__ __forceinline__ unsigned xb_xcc_id() { return (unsigned)__builtin_amdgcn_s_getreg((3 << 11) | 20) & 0xFu; }
#define XB_SPIN(cond, bar) do { unsigned _sp = 0; while (cond) { __builtin_amdgcn_s_sleep(1); \
    if ((++_sp & 255u) == 0u) { if (xb_ld(&(bar)[XB_TMO])) break; if (_sp > XB_SPIN_CAP) { atomicAdd(&(bar)[XB_TMO], 1u); break; } } } } while (0)

struct XcdBarrier {
    unsigned* bar; unsigned x;
    volatile LAS unsigned* st;
};

__device__ __forceinline__ XcdBarrier xcd_barrier_post(unsigned* bar, volatile LAS unsigned* st) {
    XcdBarrier b; b.bar = bar; b.x = xb_xcc_id(); b.st = st;
    if (threadIdx.x == 0) (void)xb_add(&bar[XB_XCNT(b.x)], 1u);
    return b;
}
__device__ __forceinline__ void xcd_barrier_complete(unsigned* bar, unsigned x, unsigned& nloc, unsigned& nx) {
    const unsigned G = gridDim.x * gridDim.y * gridDim.z;
    unsigned sum, cnt, mine, sp = 0u;
    for (;;) {
        sum = 0u; cnt = 0u; mine = 0u;
#pragma unroll
        for (unsigned j = 0; j < 16; ++j) { const unsigned c = xb_ld(&bar[XB_XCNT(j)]); sum += c; cnt += (c > 0u) ? 1u : 0u; mine = (j == x) ? c : mine; }
        if (sum == G) break;
        __builtin_amdgcn_s_sleep(1);
        if ((++sp & 255u) == 0u) { if (xb_ld(&bar[XB_TMO])) break; if (sp > XB_SPIN_CAP) { atomicAdd(&bar[XB_TMO], 1u); break; } }
    }
    nloc = mine > 0u ? mine : 1u; nx = cnt > 0u ? cnt : 1u;
}

__device__ __forceinline__ void xcd_barrier(const XcdBarrier& b) {
    asm volatile("s_waitcnt vmcnt(0)" ::: "memory");
    __syncthreads();
    if (threadIdx.x == 0) {
        unsigned* bar = b.bar;
        __builtin_amdgcn_s_waitcnt(0);
        unsigned nloc = b.st[0], nx = b.st[1];
        if (nloc == 0u) { xcd_barrier_complete(bar, b.x, nloc, nx); b.st[0] = nloc; b.st[1] = nx; }
        const unsigned old = xb_add(&bar[XB_XSUB(b.x)], 1u);
        const unsigned gen = old / nloc;
        if (old + 1u == (gen + 1u) * nloc) {
            __builtin_amdgcn_fence(__ATOMIC_RELEASE, "agent");
            asm volatile("s_waitcnt vmcnt(0)" ::: "memory");
            const unsigned og = xb_add(&bar[XB_TOP], 1u);
            const unsigned tg = og / nx;
            if (og + 1u == (tg + 1u) * nx) xb_add(&bar[XB_TOPGEN], 1u);
            else XB_SPIN(xb_ld(&bar[XB_TOPGEN]) == tg, bar);
            __builtin_amdgcn_fence(__ATOMIC_ACQUIRE, "agent");
            xb_add(&bar[XB_XGEN(b.x)], 1u);
            asm volatile("s_waitcnt vmcnt(0)" ::: "memory");
        } else {
            XB_SPIN(xb_ld(&bar[XB_XGEN(b.x)]) == gen, bar);
            __builtin_amdgcn_fence(__ATOMIC_ACQUIRE, "agent");
            asm volatile("s_waitcnt vmcnt(0)" ::: "memory");
        }
    }
    __syncthreads();
}

struct Ctx { int tid, lane, wave, blk, nblk; LAS unsigned char* lds; };
#define LDS_WAIT() asm volatile("s_waitcnt lgkmcnt(0)" ::: "memory")

__device__ __forceinline__ float wave_sum(float v) {
#pragma unroll
    for (int o = 1; o < 64; o <<= 1) v += __shfl_xor(v, o);
    return v;
}

__device__ __forceinline__ void prologue(const Params& P, const Ctx& C) {
    const int gw = C.blk * NWAVE + C.wave, NGW = C.nblk * NWAVE;
    {
        LAS float* scr = (LAS float*)(C.lds + C.wave * 16384);
        const int matN[8] = {4096, 768, 1024, 2048, 0, 1024, 5632, 1024};
        const int matK[8] = {1024, 256, 256, 1024, 64, 1024, 1024, 2816};
        const size_t matO[8] = {WO_IN, WO_Q, WO_KV, WO_A, WO_H, WO_O, WO_GU, WO_D};
        constexpr int ITEMS_L = 2048 + 96 + 128 + 1024 + 0 + 512 + 2816 + 1408;
        for (int it = gw; it < 2 * ITEMS_L; it += NGW) {
            const int l = it / ITEMS_L; int r = it % ITEMS_L; int mat = 0;
#pragma unroll
            for (int q = 0; q < 8; ++q) { const int ni = (matK[q] / 64) * (matN[q] / 32); if (mat == q && r >= ni) { r -= ni; mat = q + 1; } }
            int N = 0, K = 0; size_t off = 0;
#pragma unroll
            for (int q = 0; q < 8; ++q) if (mat == q) { N = matN[q]; K = matK[q]; off = matO[q]; }
            bf16_t* WT = mat == 3 ? (bf16_t*)(P.ws + WS_WM + (size_t)l * WM_LAYER) : (bf16_t*)(P.ws + WS_W + (size_t)l * W_LAYER + off);
            const int nblk = N / 32, kb = r / nblk, nb = r % nblk, k0 = 64 * kb, n0 = 32 * nb, n = n0 + (C.lane & 31);
            const float* colp = P.in[3]; int ldw = 0, kmax = K, kmin = 0; const float* gp = nullptr; bool valid = true;
            switch (mat) {
            case 0: { const int sc = n < 416 ? n : (n < 512 ? -1 : n - 96); valid = sc >= 0; colp = P.in[3] + (size_t)l * DM * INC + (valid ? sc : 0); ldw = INC; gp = P.in[2] + l * DM; } break;
            case 1: colp = P.in[5] + (size_t)l * QL * 768 + n; ldw = 768; gp = P.in[4] + l * QL; break;
            case 2: colp = P.in[7] + (size_t)l * KVL * 1024 + n; ldw = 1024; gp = P.in[6] + l * KVL; kmax = KVL; break;
            case 3: { const int bj = (n >> 7) & 1, col = (n >> 8) * 128 + (n & 127); ldw = DM;
                      if (bj == 0) { colp = P.in[8] + (size_t)l * 512 * DM + col; kmax = 512; } else { colp = P.in[22] + (size_t)l * DHY * DM + col; kmin = 512; } } break;
            case 4: break;
            case 5: colp = P.in[23] + (size_t)l * DM * DM + n; ldw = DM; break;
            case 6: { const int sel = (n >> 2) & 1, col = (n >> 3) * 4 + (n & 3); colp = P.in[sel ? 26 : 25] + (size_t)l * DM * DFF + col; ldw = DFF; gp = P.in[24] + l * DM; } break;
            default: colp = P.in[27] + (size_t)l * DFF * DM + n; ldw = DM; break;
            }
            float v[32];
#pragma unroll
            for (int i = 0; i < 32; ++i) { const int k = k0 + 2 * i + (C.lane >> 5); const int kc = (k < kmax && k >= kmin) ? k - kmin : 0; v[i] = colp[(size_t)kc * ldw]; }
            if (gp) {
#pragma unroll
                for (int i = 0; i < 32; ++i) { const int k = k0 + 2 * i + (C.lane >> 5); const int kc = k < kmax ? k : 0; v[i] *= gp[kc]; } }
            if (mat == 1) {
#pragma unroll
                for (int i = 0; i < 32; ++i) v[i] *= att::QSCALE; }
#pragma unroll
            for (int i = 0; i < 32; ++i) { const int kk = 2 * i + (C.lane >> 5); scr[kk * 33 + (C.lane & 31)] = (valid && (k0 + kk) < kmax && (k0 + kk) >= kmin) ? v[i] : 0.f; }
            LDS_WAIT();
            const int c = C.lane & 7;
#pragma unroll
            for (int j = 0; j < 4; ++j) { const int nn = (C.lane >> 3) + 8 * j; const LAS float* sp = scr + (8 * c) * 33 + nn;
                u32x4 o; o.x = pk2(sp[0 * 33], sp[1 * 33]); o.y = pk2(sp[2 * 33], sp[3 * 33]); o.z = pk2(sp[4 * 33], sp[5 * 33]); o.w = pk2(sp[6 * 33], sp[7 * 33]);
                *(u32x4*)(WT + (size_t)(n0 + nn) * K + k0 + 8 * c) = o; }
            LDS_WAIT();
        }
    }
    {
        f32x2* cs = (f32x2*)(P.ws + WS_ROPE); const int* pos = (const int*)P.in[1];
        for (int idx = C.blk * NTHR + C.tid; idx < SEQ * 16; idx += C.nblk * NTHR) {
            const int s = idx >> 4, i = idx & 15; const float inv = 1.0f / powf(10000.0f, (float)(2 * i) / 32.0f); const float a = (float)pos[s] * inv;
            cs[idx] = (f32x2){cosf(a), sinf(a)}; }
    }
    {
        bf16_t* taps = (bf16_t*)(P.ws + WS_TAPS);
        for (int task = gw; task < 2 * (SEQ / 4); task += NGW) {
            const int l = task >> 9, p0 = (task & 511) * 4, lane = C.lane;
            const float* w1 = P.in[11] + l * 33 * 64; const float* w2 = P.in[14] + l * 4096; const float* w3 = P.in[17] + l * 4096; const float* w4 = P.in[20] + (size_t)l * 64 * 1024;
            float zv[4], tq[4], h[4], a[4];
#pragma unroll
            for (int q = 0; q < 4; ++q) { const int p = p0 + q; tq[q] = (float)p / 2047.0f; const float w = 6.283185307179586f * (float)p / 2048.0f;
                float z = 0.f;
                if (lane == 0) z = tq[q];
                else if (lane <= 16) { const float fr = 1e-4f + (float)(lane - 1) * ((15.0f - 1e-4f) / 15.0f); z = cosf(fr * w); }
                else if (lane <= 32) { const float fr = 1e-4f + (float)(lane - 17) * ((15.0f - 1e-4f) / 15.0f); z = -sinf(fr * w); }
                zv[q] = z; a[q] = 0.f; }
#pragma unroll 1
            for (int e0 = 0; e0 < 33; e0 += 11) { float wv[11];
#pragma unroll
                for (int j = 0; j < 11; ++j) wv[j] = w1[(e0 + j) * 64 + lane];
#pragma unroll
                for (int j = 0; j < 11; ++j) {
#pragma unroll
                    for (int q = 0; q < 4; ++q) a[q] += __shfl(zv[q], e0 + j) * wv[j]; } }
            { const float ff = P.in[13][l * 64 + lane], bb = P.in[12][l * 64 + lane];
#pragma unroll
              for (int q = 0; q < 4; ++q) { h[q] = sinf(ff * (a[q] + bb)); a[q] = 0.f; } }
            asm volatile("" ::: "memory");
#pragma unroll 1
            for (int k0 = 0; k0 < 64; k0 += 16) { float wv[16];
#pragma unroll
                for (int j = 0; j < 16; ++j) wv[j] = w2[(k0 + j) * 64 + lane];
#pragma unroll
                for (int j = 0; j < 16; ++j) {
#pragma unroll
                    for (int q = 0; q < 4; ++q) a[q] += __shfl(h[q], k0 + j) * wv[j]; } }
            { const float ff = P.in[16][l * 64 + lane], bb = P.in[15][l * 64 + lane];
#pragma unroll
              for (int q = 0; q < 4; ++q) { h[q] = sinf(ff * (a[q] + bb)); a[q] = 0.f; } }
            asm volatile("" ::: "memory");
#pragma unroll 1
            for (int k0 = 0; k0 < 64; k0 += 16) { float wv[16];
#pragma unroll
                for (int j = 0; j < 16; ++j) wv[j] = w3[(k0 + j) * 64 + lane];
#pragma unroll
                for (int j = 0; j < 16; ++j) {
#pragma unroll
                    for (int q = 0; q < 4; ++q) a[q] += __shfl(h[q], k0 + j) * wv[j]; } }
            { const float ff = P.in[19][l * 64 + lane], bb = P.in[18][l * 64 + lane];
#pragma unroll
              for (int q = 0; q < 4; ++q) h[q] = sinf(ff * (a[q] + bb)); }
            asm volatile("" ::: "memory");
            float o[4][16];
#pragma unroll
            for (int q = 0; q < 4; ++q)
#pragma unroll
                for (int m = 0; m < 16; ++m) o[q][m] = 0.f;
#pragma unroll 2
            for (int k = 0; k < 64; ++k) {
                float ww[16];
#pragma unroll
                for (int m = 0; m < 16; ++m) ww[m] = w4[k * 1024 + lane + 64 * m];
#pragma unroll
                for (int q = 0; q < 4; ++q) { const float hk = __shfl(h[q], k);
#pragma unroll
                    for (int m = 0; m < 16; ++m) o[q][m] += hk * ww[m]; } }
            const float dlo = -15.350567286626974f, dhi = -3.0701134573253946f;
#pragma unroll
            for (int m = 0; m < 16; ++m) {
                const int n = lane + 64 * m, c = n & 511;
                const float delta = fabsf(dlo + (float)c * ((dhi - dlo) / 511.0f));
                const float skip = P.in[21][l * DHY + c];
#pragma unroll
                for (int q = 0; q < 4; ++q) {
                    const int p = p0 + q;
                    float val = o[q][m] * expf(-tq[q] * delta);
                    int idx;
                    if (n < 512) { idx = 2047 - p; if (p == 0) val += skip; }
                    else { idx = 2047 + p; if (p == 0) { idx = 4095; val = 0.f; } }
                    taps[((size_t)(l * DHY + c)) * 4096 + idx] = (bf16_t)f2bf(val);
                }
            }
        }
    }
}

__device__ __forceinline__ void xcast_rows(const Ctx& C, const float* x, bf16_t* out, float* ssq) {
    const int gw = C.blk * NWAVE + C.wave, NGW = C.nblk * NWAVE;
    for (int m = gw; m < MTOK; m += NGW) {
        const f32x4* xr = (const f32x4*)(x + (size_t)m * DM) + C.lane;
        f32x4 v[4]; float s = 0.f;
#pragma unroll
        for (int j = 0; j < 4; ++j) { v[j] = xr[64 * j]; s += (v[j].x * v[j].x + v[j].y * v[j].y) + (v[j].z * v[j].z + v[j].w * v[j].w); }
        s = wave_sum(s);
        if (C.lane < 4) ssq[(size_t)m * 4 + C.lane] = C.lane == 0 ? s : 0.f;
        u32x2* o8 = (u32x2*)(out + (size_t)m * DM) + C.lane;
#pragma unroll
        for (int j = 0; j < 4; ++j) { u32x2 w; w.x = cvt_pk_bf16(v[j].x, v[j].y); w.y = cvt_pk_bf16(v[j].z, v[j].w); o8[64 * j] = w; }
    }
}
__device__ __forceinline__ void rmsnorm_final(const Ctx& C, const bf16_t* x, float* y, const float* g) {
    const int gw = C.blk * NWAVE + C.wave, NGW = C.nblk * NWAVE;
    f32x4 gv[4];
#pragma unroll
    for (int j = 0; j < 4; ++j) gv[j] = ((const f32x4*)g)[64 * j + C.lane];
    for (int m = gw; m < MTOK; m += NGW) {
        const u32x2* xr = (const u32x2*)(x + (size_t)m * DM) + C.lane; f32x4* yr = (f32x4*)(y + (size_t)m * DM) + C.lane;
        f32x4 v[4]; float s = 0.f;
#pragma unroll
        for (int j = 0; j < 4; ++j) { const u32x2 w = xr[64 * j];
            v[j] = (f32x4){__uint_as_float(w.x << 16), __uint_as_float(w.x & 0xffff0000u), __uint_as_float(w.y << 16), __uint_as_float(w.y & 0xffff0000u)};
            s += (v[j].x * v[j].x + v[j].y * v[j].y) + (v[j].z * v[j].z + v[j].w * v[j].w); }
        const float rstd = rsqrtf(wave_sum(s) * (1.0f / DM) + EPS);
#pragma unroll
        for (int j = 0; j < 4; ++j) yr[64 * j] = v[j] * rstd * gv[j];
    }
}

struct FInProj {
    bf16_t* lat; bf16_t* hyin; bf16_t* gates; const float* ssq;
    __device__ __forceinline__ float rowscale(int row) const { const f32x4 a = *(const f32x4*)(ssq + (size_t)row * 4); return rsqrtf(((a.x + a.y) + (a.z + a.w)) * (1.0f / DM) + EPS); }
    __device__ __forceinline__ void operator()(int row, int col0, f32x4 v0, f32x4 v1) const {
        bf16_t* dst;
        if (col0 < 512) dst = lat + (size_t)row * 512 + col0;
        else if (col0 < 2048) dst = hyin + (size_t)row * 1536 + (col0 - 512);
        else { dst = gates + (size_t)row * 2048 + (col0 - 2048);
#pragma unroll
            for (int e = 0; e < 4; ++e) { v0[e] = fast_sigmoid(v0[e]); v1[e] = fast_sigmoid(v1[e]); } }
        u32x4 w; w.x = cvt_pk_bf16(v0[0], v0[1]); w.y = cvt_pk_bf16(v0[2], v0[3]); w.z = cvt_pk_bf16(v1[0], v1[1]); w.w = cvt_pk_bf16(v1[2], v1[3]);
        *(u32x4*)dst = w;
    }
};
struct FPlain {
    bf16_t* dst; int ldc;
    __device__ __forceinline__ float rowscale(int) const { return 1.0f; }
    __device__ __forceinline__ void operator()(int row, int col0, f32x4 v0, f32x4 v1) const {
        u32x4 w; w.x = cvt_pk_bf16(v0[0], v0[1]); w.y = cvt_pk_bf16(v0[2], v0[3]); w.z = cvt_pk_bf16(v1[0], v1[1]); w.w = cvt_pk_bf16(v1[2], v1[3]);
        *(u32x4*)(dst + (size_t)row * ldc + col0) = w;
    }
};
struct EpiMerge2 {
    static constexpr bool PERM = true, AFTER_DRAIN = false, HALFSKIP = true;
    const bf16_t* gates; bf16_t* merged;
    __device__ __forceinline__ void operator()(const f32x4 (&acc)[2][2][4][2], const pg8::Unit& u, int wr, int wc, int fr, int fq) const {
#pragma unroll
        for (int ai = 0; ai < 2; ++ai)
#pragma unroll
            for (int mp = 0; mp < 4; mp += 2) {
                u32x4 ga[2], gb[2];
#pragma unroll
                for (int q = 0; q < 2; ++q) { const size_t g = (size_t)(u.pm * 256 + ai * 128 + wr * 64 + (mp + q) * 16 + fr) * 2048 + u.pn * 128 + wc * 32 + 8 * fq;
                    ga[q] = *(const u32x4*)(gates + g); gb[q] = *(const u32x4*)(gates + g + 1024); }
#pragma unroll
                for (int q = 0; q < 2; ++q) { const int m = mp + q, row = u.pm * 256 + ai * 128 + wr * 64 + m * 16 + fr;
                    float a[8], b[8], o[8]; unpack8(ga[q], a); unpack8(gb[q], b);
#pragma unroll
                    for (int e = 0; e < 4; ++e) { o[e] = a[e] * acc[ai][0][m][0][e] + b[e] * acc[ai][1][m][0][e]; o[4 + e] = a[4 + e] * acc[ai][0][m][1][e] + b[4 + e] * acc[ai][1][m][1][e]; }
                    *(u32x4*)(merged + (size_t)row * DM + u.pn * 128 + wc * 32 + 8 * fq) = pack8(o); }
                asm volatile("" ::: "memory"); }
    }
};
struct FSwiglu {
    bf16_t* act; const float* ssq;
    __device__ __forceinline__ float rowscale(int row) const { const f32x4 a = *(const f32x4*)(ssq + (size_t)row * 4); return rsqrtf(((a.x + a.y) + (a.z + a.w)) * (1.0f / DM) + EPS); }
    __device__ __forceinline__ void operator()(int row, int col0, f32x4 v0, f32x4 v1) const {
        float o[4];
#pragma unroll
        for (int e = 0; e < 4; ++e) o[e] = v0[e] * fast_sigmoid(v0[e]) * v1[e];
        u32x2 w; w.x = cvt_pk_bf16(o[0], o[1]); w.y = cvt_pk_bf16(o[2], o[3]);
        *(u32x2*)(act + (size_t)row * DFF + (col0 >> 1)) = w;
    }
};
struct EpiResid {
    static constexpr bool PERM = false, AFTER_DRAIN = false, HALFSKIP = false;
    const float* base; float* out; bf16_t* xb; float* ssq;
    __device__ __forceinline__ void operator()(const f32x4 (&acc)[2][2][4][2], const pg8::Unit& u, int wr, int wc, int fr, int fq) const {
#pragma unroll
        for (int ai = 0; ai < 2; ++ai) {
            f32x4 r[4][2][2];
#pragma unroll
            for (int m = 0; m < 4; ++m)
#pragma unroll
                for (int bj = 0; bj < 2; ++bj)
#pragma unroll
                    for (int n = 0; n < 2; ++n) r[m][bj][n] = *(const f32x4*)(base + (size_t)(u.pm * 256 + ai * 128 + wr * 64 + m * 16 + fr) * DM + u.pn * 256 + bj * 128 + wc * 32 + 16 * n + 4 * fq);
#pragma unroll
            for (int m = 0; m < 4; ++m) { const int row = u.pm * 256 + ai * 128 + wr * 64 + m * 16 + fr; float s = 0.f;
#pragma unroll
                for (int bj = 0; bj < 2; ++bj)
#pragma unroll
                    for (int n = 0; n < 2; ++n) { const size_t off = (size_t)row * DM + u.pn * 256 + bj * 128 + wc * 32 + 16 * n + 4 * fq;
                        const f32x4 o = r[m][bj][n] + acc[ai][bj][m][n]; *(f32x4*)(out + off) = o;
                        if (xb) { u32x2 w; w.x = cvt_pk_bf16(o[0], o[1]); w.y = cvt_pk_bf16(o[2], o[3]); *(u32x2*)(xb + off) = w; }
                        s += (o[0] * o[0] + o[1] * o[1]) + (o[2] * o[2] + o[3] * o[3]); }
                s += __shfl_xor(s, 16); s += __shfl_xor(s, 32);
                if (xb && fq == 0) unsafeAtomicAdd(ssq + row, s); }
            asm volatile("" ::: "memory"); }
    }
};
struct EpiResidB {
    static constexpr bool PERM = true, AFTER_DRAIN = false, HALFSKIP = false;
    bf16_t* xb; float* ssq; LAS float* tab;
    __device__ __forceinline__ void operator()(const f32x4 (&acc)[2][2][4][2], const pg8::Unit& u, int wr, int wc, int fr, int fq) const {
#pragma unroll
        for (int ai = 0; ai < 2; ++ai) {
            u32x4 r[4][2];
#pragma unroll
            for (int m = 0; m < 4; ++m)
#pragma unroll
                for (int bj = 0; bj < 2; ++bj) r[m][bj] = *(const u32x4*)(xb + (size_t)(u.pm * 256 + ai * 128 + wr * 64 + m * 16 + fr) * DM + u.pn * 256 + bj * 128 + wc * 32 + 8 * fq);
#pragma unroll
            for (int m = 0; m < 4; ++m) { const int rl = ai * 128 + wr * 64 + m * 16 + fr, row = u.pm * 256 + rl; float s = 0.f;
#pragma unroll
                for (int bj = 0; bj < 2; ++bj) { float f[8], o[8]; unpack8(r[m][bj], f);
#pragma unroll
                    for (int e = 0; e < 4; ++e) { o[e] = f[e] + acc[ai][bj][m][0][e]; o[4 + e] = f[4 + e] + acc[ai][bj][m][1][e]; }
#pragma unroll
                    for (int e = 0; e < 8; ++e) s += o[e] * o[e];
                    *(u32x4*)(xb + (size_t)row * DM + u.pn * 256 + bj * 128 + wc * 32 + 8 * fq) = pack8(o); }
                s += __shfl_xor(s, 16); s += __shfl_xor(s, 32);
                if (fq == 0) tab[rl * 4 + wc] = s; }
            asm volatile("" ::: "memory"); }
        asm volatile("s_waitcnt lgkmcnt(0)\n\ts_barrier" ::: "memory");
        const int t = wr * 256 + wc * 64 + fq * 16 + fr;
        if (t < 256) { const f32x4 p = *(const LAS f32x4*)(tab + t * 4); ssq[(size_t)(u.pm * 256 + t) * 4 + u.pn] = (p.x + p.y) + (p.z + p.w); }
    }
};
struct EpiResidF {
    static constexpr bool PERM = true, AFTER_DRAIN = false, HALFSKIP = false;
    const bf16_t* xb; bf16_t* xf;
    __device__ __forceinline__ void operator()(const f32x4 (&acc)[2][2][4][2], const pg8::Unit& u, int wr, int wc, int fr, int fq) const {
#pragma unroll
        for (int ai = 0; ai < 2; ++ai) {
            u32x4 r[4][2];
#pragma unroll
            for (int m = 0; m < 4; ++m)
#pragma unroll
                for (int bj = 0; bj < 2; ++bj) r[m][bj] = *(const u32x4*)(xb + (size_t)(u.pm * 256 + ai * 128 + wr * 64 + m * 16 + fr) * DM + u.pn * 256 + bj * 128 + wc * 32 + 8 * fq);
#pragma unroll
            for (int m = 0; m < 4; ++m) { const int row = u.pm * 256 + ai * 128 + wr * 64 + m * 16 + fr;
#pragma unroll
                for (int bj = 0; bj < 2; ++bj) { float f[8], o[8]; unpack8(r[m][bj], f);
#pragma unroll
                    for (int e = 0; e < 4; ++e) { o[e] = f[e] + acc[ai][bj][m][0][e]; o[4 + e] = f[4 + e] + acc[ai][bj][m][1][e]; }
                    *(u32x4*)(xf + (size_t)row * DM + u.pn * 256 + bj * 128 + wc * 32 + 8 * fq) = pack8(o); } }
            asm volatile("" ::: "memory"); }
    }
};
template <class E>
__device__ __forceinline__ void run_gemm_epi(const Ctx& C, const bf16_t* A, int lda, const bf16_t* Bt, int N, int K, const E& e) {
    pg8::Gemm g{A, Bt, MTOK, N, K, lda}; pg8::StaticOrder S; S.init(MTOK, N, C.nblk, C.blk);
#if FAST_GEMM
    pg8::gemm_phase<E, pg8::StaticOrder, true, true>(C.lds, g, S, e);
#else
    pg8::gemm_simple<E, pg8::StaticOrder>(g, S, e);
#endif
}

template <class F, bool P8> struct EpiSel { typedef pg8::Epi8<F> type; };
template <class F> struct EpiSel<F, false> { typedef pg8::Epi4<F> type; };
template <bool P8, bool SIMPLE = false, class F>
__device__ __forceinline__ void run_gemm(const Ctx& C, const bf16_t* A, int lda, const bf16_t* Bt, int N, int K, const F& f) {
    typedef typename EpiSel<F, P8>::type E; E e{f};
    pg8::Gemm g{A, Bt, MTOK, N, K, lda}; pg8::StaticOrder S; S.init(MTOK, N, C.nblk, C.blk);
#if FAST_GEMM
    if constexpr (SIMPLE) pg8::gemm_simple<E, pg8::StaticOrder>(g, S, e);
    else pg8::gemm_phase<E, pg8::StaticOrder, true, true>(C.lds, g, S, e);
#else
    pg8::gemm_simple<E, pg8::StaticOrder>(g, S, e);
#endif
}

__device__ __forceinline__ void lat_rows(const Ctx& C, bf16_t* lat, const f32x2* cs, bf16_t* kpe) {
    const int gw = C.blk * NWAVE + C.wave, NGW = C.nblk * NWAVE, lane = C.lane;
    for (int m0 = gw * 4; m0 < MTOK; m0 += NGW * 4) {
        u32x4 raw[4];
#pragma unroll
        for (int r = 0; r < 4; ++r) raw[r] = *(const u32x4*)(lat + (size_t)(m0 + r) * 512 + 8 * lane);
#pragma unroll
        for (int r = 0; r < 4; ++r) {
            const int m = m0 + r; bf16_t* lp = lat + (size_t)m * 512 + 8 * lane;
            float f[8]; unpack8(raw[r], f);
            float s = 0.f;
#pragma unroll
            for (int e = 0; e < 8; ++e) s += f[e] * f[e];
            s += __shfl_xor(s, 1); s += __shfl_xor(s, 2); s += __shfl_xor(s, 4); s += __shfl_xor(s, 8);
            const float s32 = s + __shfl_xor(s, 16);
            const float rs = lane < 32 ? rsqrtf(s32 * (1.0f / QL) + EPS) : rsqrtf(s * (1.0f / KVL) + EPS);
            if (lane < 48) {
#pragma unroll
                for (int e = 0; e < 8; ++e) f[e] *= rs;
                *(u32x4*)lp = pack8(f);
            } else if (lane < 52) {
                const int sq = m & 2047, i0 = (lane - 48) * 4; const f32x2* c = cs + sq * 16 + i0;
                float o[8];
#pragma unroll
                for (int p = 0; p < 4; ++p) { const f32x2 cc = c[p]; o[2 * p] = f[2 * p] * cc.x - f[2 * p + 1] * cc.y; o[2 * p + 1] = f[2 * p] * cc.y + f[2 * p + 1] * cc.x; }
                *(u32x4*)(kpe + (size_t)m * ROPE + 8 * (lane - 48)) = pack8(o);
            }
        }
    }
}
constexpr int TR_RS = 1028;
__device__ __forceinline__ void hy_load10(const bf16_t* base, int t0, int cg, u32x4* rows) {
#pragma unroll
    for (int i = 0; i < 10; ++i) { const int t = t0 - 1 + i; const int tc = t < 0 ? 0 : (t > SEQ - 1 ? SEQ - 1 : t);
        u32x4 v = *(const u32x4*)(base + (size_t)tc * 1536 + 8 * cg);
        if (t < 0 || t > SEQ - 1) v = (u32x4){0u, 0u, 0u, 0u};
        rows[i] = v; }
}
__device__ __forceinline__ void hy_conv_row(const u32x4& ra, const u32x4& rb, const u32x4& rc, const float* w0, const float* w1, const float* w2, const float* bias, float* o) {
    float a[8], b[8], c[8]; unpack8(ra, a); unpack8(rb, b); unpack8(rc, c);
#pragma unroll
    for (int e = 0; e < 8; ++e) o[e] = a[e] * w0[e] + b[e] * w1[e] + c[e] * w2[e] + bias[e];
}
__device__ __forceinline__ void hy_pre(const Ctx& C, const bf16_t* hyin, const float* cw, const float* cb, bf16_t* x0c, bf16_t* zT) {
    const int cg = C.tid & 63, tw = C.tid >> 6;
    float w[3][3][8], bs[3][8];
#pragma unroll
    for (int q = 0; q < 3; ++q) {
#pragma unroll
        for (int k = 0; k < 3; ++k)
#pragma unroll
            for (int e = 0; e < 8; ++e) w[q][k][e] = cw[k * 1536 + q * 512 + 8 * cg + e];
#pragma unroll
        for (int e = 0; e < 8; ++e) bs[q][e] = cb[q * 512 + 8 * cg + e];
    }
    for (int it = C.blk; it < NB * (SEQ / 64); it += C.nblk) {
        const int b = it >> 5, t0 = (it & 31) * 64, tb = t0 + tw * 8;
        const bf16_t* hb = hyin + (size_t)b * SEQ * 1536;
        __syncthreads();
        {   u32x4 r0[10]; hy_load10(hb, tb, cg, r0);
#pragma unroll
            for (int tt = 0; tt < 8; ++tt) { float o0[8]; hy_conv_row(r0[tt], r0[tt + 1], r0[tt + 2], w[0][0], w[0][1], w[0][2], bs[0], o0);
                *(u32x4*)(x0c + ((size_t)b * SEQ + tb + tt) * DHY + 8 * cg) = pack8(o0); } }
        asm volatile("" ::: "memory");
#pragma unroll 1
        for (int hh = 0; hh < 2; ++hh) {
            u32x4 r1[6], r2[6];
#pragma unroll
            for (int i = 0; i < 6; ++i) { const int t = tb + 4 * hh - 1 + i; const int tc = t < 0 ? 0 : (t > SEQ - 1 ? SEQ - 1 : t); const bool oob = (t < 0 || t > SEQ - 1);
                u32x4 v1 = *(const u32x4*)(hb + 512 + (size_t)tc * 1536 + 8 * cg), v2 = *(const u32x4*)(hb + 1024 + (size_t)tc * 1536 + 8 * cg);
                if (oob) { v1 = (u32x4){0u, 0u, 0u, 0u}; v2 = (u32x4){0u, 0u, 0u, 0u}; }
                r1[i] = v1; r2[i] = v2; }
#pragma unroll
            for (int tt = 0; tt < 4; ++tt) { float o1[8], o2[8], z[8];
                hy_conv_row(r1[tt], r1[tt + 1], r1[tt + 2], w[1][0], w[1][1], w[1][2], bs[1], o1);
                hy_conv_row(r2[tt], r2[tt + 1], r2[tt + 2], w[2][0], w[2][1], w[2][2], bs[2], o2);
#pragma unroll
                for (int e = 0; e < 8; ++e) z[e] = o2[e] * o1[e];
                const u32x4 zw = pack8(z);
                LAS unsigned* d = (LAS unsigned*)(C.lds + (tw * 8 + 4 * hh + tt) * TR_RS + 16 * cg);
                d[0] = zw.x; d[1] = zw.y; d[2] = zw.z; d[3] = zw.w; } }
        __syncthreads();
        const int ch = C.tid & 7;
        for (int ps = 0; ps < 8; ++ps) {
            const int c = (C.tid >> 3) + 64 * ps;
            unsigned short v[8];
#pragma unroll
            for (int j = 0; j < 8; ++j) v[j] = *(const LAS unsigned short*)(C.lds + (8 * ch + j) * TR_RS + 2 * c);
            u32x4 o; o.x = v[0] | ((unsigned)v[1] << 16); o.y = v[2] | ((unsigned)v[3] << 16); o.z = v[4] | ((unsigned)v[5] << 16); o.w = v[6] | ((unsigned)v[7] << 16);
            *(u32x4*)(zT + ((size_t)c * NB + b) * SEQ + t0 + 8 * ch) = o;
        }
    }
}
__device__ __forceinline__ void hy_post(const Ctx& C, const bf16_t* yT, const bf16_t* x0c, bf16_t* oy) {
    const int cg = C.tid & 63, tw = C.tid >> 6, ch = C.tid & 7;
    for (int it = C.blk; it < NB * (SEQ / 64); it += C.nblk) {
        const int b = it >> 5, t0 = (it & 31) * 64;
        __syncthreads();
        for (int ps = 0; ps < 8; ++ps) {
            const int c = (C.tid >> 3) + 64 * ps;
            const u32x4 o = *(const u32x4*)(yT + ((size_t)c * NB + b) * SEQ + t0 + 8 * ch);
            const unsigned short v[8] = {(unsigned short)(o.x & 0xffff), (unsigned short)(o.x >> 16), (unsigned short)(o.y & 0xffff), (unsigned short)(o.y >> 16),
                                         (unsigned short)(o.z & 0xffff), (unsigned short)(o.z >> 16), (unsigned short)(o.w & 0xffff), (unsigned short)(o.w >> 16)};
#pragma unroll
            for (int j = 0; j < 8; ++j) *(LAS unsigned short*)(C.lds + (8 * ch + j) * TR_RS + 2 * c) = v[j];
        }
        __syncthreads();
        u32x4 xr[8];
#pragma unroll
        for (int tt = 0; tt < 8; ++tt) xr[tt] = *(const u32x4*)(x0c + ((size_t)b * SEQ + t0 + tw * 8 + tt) * DHY + 8 * cg);
#pragma unroll
        for (int tt = 0; tt < 8; ++tt) {
            const int tl = tw * 8 + tt, t = t0 + tl;
            const LAS unsigned* sp = (const LAS unsigned*)(C.lds + tl * TR_RS + 16 * cg);
            u32x4 yw; yw.x = sp[0]; yw.y = sp[1]; yw.z = sp[2]; yw.w = sp[3];
            float y[8], x[8]; unpack8(yw, y); unpack8(xr[tt], x);
#pragma unroll
            for (int e = 0; e < 8; ++e) y[e] *= x[e];
            *(u32x4*)(oy + ((size_t)b * SEQ + t) * 1024 + 512 + 8 * cg) = pack8(y);
        }
    }
}

namespace att {
constexpr int NW = 8, QBLK = 32, KVBLK = 64;
constexpr float SCALE = 0.10206207261596575f;
constexpr float THR = 8.f;
constexpr int SHM_V = KVBLK * VH * 2  , SHM_K = KVBLK * 256  ;
constexpr int NSLOT = 3;
constexpr int LDS_ATT = NSLOT * SHM_V + NSLOT * SHM_K + NW * 64 * 4;
#define KSWZ(row, colB) ((row) * 256 + ((colB) ^ (((row) & 7) << 4)))
#define SBAR() __builtin_amdgcn_sched_barrier(0)
__device__ __forceinline__ int crow(int r, int hi) { return (r & 3) + 8 * (r >> 2) + 4 * hi; }
__device__ __forceinline__ unsigned cvtpk(float lo, float hi) { unsigned r; asm volatile("v_cvt_pk_bf16_f32 %0, %1, %2" : "=v"(r) : "v"(lo), "v"(hi)); return r; }

template <bool FIRST>
__device__ __forceinline__ void partialSM(f32x16& p0, f32x16& p1, float& M, f32x16& negm, float& alpha) {
  constexpr float THR2 = THR * 1.4426950408889634f;
#define MX3(a, b, c) __builtin_fmaxf(__builtin_fmaxf((a), (b)), (c))
  float a = MX3(p0[0], p0[1], p1[0]), b = MX3(p0[2], p0[3], p1[1]); a = MX3(a, p1[2], p1[3]);
#pragma unroll
  for (int r = 4; r < 16; r += 4) { a = MX3(a, p0[r], p0[r + 1]); b = MX3(b, p0[r + 2], p0[r + 3]); a = MX3(a, p1[r], p1[r + 1]); b = MX3(b, p1[r + 2], p1[r + 3]); }
#undef MX3
  float pmax = fmaxf(a, b);
  { auto rr = __builtin_amdgcn_permlane32_swap(__float_as_uint(pmax), __float_as_uint(pmax), false, false);
    pmax = fmaxf(__uint_as_float(rr[0]), __uint_as_float(rr[1])); }
  alpha = 1.f;
  if (FIRST || !__builtin_expect(__all(pmax <= THR2), 1)) {
    const float dl = FIRST ? pmax : fmaxf(pmax, 0.f);
#pragma unroll
    for (int r = 0; r < 16; ++r) { p0[r] -= dl; p1[r] -= dl; }
    M += dl;
#pragma unroll
    for (int r = 0; r < 16; ++r) negm[r] = -M;
    if (!FIRST) alpha = __builtin_amdgcn_exp2f(-dl);
  }
#pragma unroll
  for (int r = 0; r < 16; ++r) p0[r] = __builtin_amdgcn_exp2f(p0[r]);
}
__device__ __forceinline__ void finishSM(f32x16& p0, f32x16& p1, float alpha, float& l_reg, bf16x8& pa0, bf16x8& pa1, bf16x8& pa2, bf16x8& pa3) {
#pragma unroll
  for (int r = 0; r < 16; ++r) p1[r] = __builtin_amdgcn_exp2f(p1[r]);
  f32x2 s2 = (f32x2){p0[0], p0[1]};
#pragma unroll
  for (int r = 2; r < 16; r += 2) s2 += (f32x2){p0[r], p0[r + 1]};
#pragma unroll
  for (int r = 0; r < 16; r += 2) s2 += (f32x2){p1[r], p1[r + 1]};
  float ps = s2.x + s2.y;
  { auto rr = __builtin_amdgcn_permlane32_swap(__float_as_uint(ps), __float_as_uint(ps), false, false);
    ps = __uint_as_float(rr[0]) + __uint_as_float(rr[1]); }
  l_reg = l_reg * alpha + ps;
#define PK4(P, BASE, OUT) do { u32x4 w = {cvtpk(P[BASE + 0], P[BASE + 1]), cvtpk(P[BASE + 2], P[BASE + 3]), cvtpk(P[BASE + 4], P[BASE + 5]), cvtpk(P[BASE + 6], P[BASE + 7])}; \
    OUT = *reinterpret_cast<bf16x8*>(&w); } while (0)
  PK4(p0, 0, pa0); PK4(p0, 8, pa1); PK4(p1, 0, pa2); PK4(p1, 8, pa3);
#undef PK4
}
__device__ __forceinline__ void qkt(f32x16& p0, f32x16& p1, const char* Ks, const bf16x8* qr, const f32x16& negm, int r32, int hi) {
#pragma unroll
  for (int d0 = 0; d0 < 6; ++d0) { int cb = (d0 * 16 + hi * 8) * 2;
    bf16x8 b0 = *reinterpret_cast<const bf16x8*>(Ks + KSWZ(r32, cb));
    bf16x8 b1 = *reinterpret_cast<const bf16x8*>(Ks + KSWZ(32 + r32, cb));
    if (d0 == 0) { p0 = __builtin_amdgcn_mfma_f32_32x32x16_bf16(b0, qr[0], negm, 0, 0, 0); p1 = __builtin_amdgcn_mfma_f32_32x32x16_bf16(b1, qr[0], negm, 0, 0, 0); }
    else { p0 = __builtin_amdgcn_mfma_f32_32x32x16_bf16(b0, qr[d0], p0, 0, 0, 0); p1 = __builtin_amdgcn_mfma_f32_32x32x16_bf16(b1, qr[d0], p1, 0, 0, 0); } }
}
__device__ __forceinline__ int v_st(int k, int c) { const int kk = k; return ((kk >> 3) * 2 + (c >> 5)) * 512 + ((kk & 7) * 32 + (c & 31)) * 2; }
__device__ __forceinline__ int v_rd_base(int lane) { return ((lane & 3) << 3) | (((lane >> 2) & 3) << 6) | (((lane >> 4) & 1) << 5) | (((lane >> 5) & 1) << 8); }
constexpr int v_rd_off(int d0, int ks, int half) { return d0 * 512 + ks * 2048 + half * 1024; }
template <int OFF> __device__ __forceinline__ s16x4 tr_read(int vb) {
  s16x4 r; asm volatile("ds_read_b64_tr_b16 %0, %1 offset:%2" : "=&v"(r) : "v"(vb), "i"(OFF) : "memory"); return r;
}
template <int D0> __device__ __forceinline__ void pv_one(f32x16& od, int vb, bf16x8 pa0, bf16x8 pa1, bf16x8 pa2, bf16x8 pa3) {
  const s16x4 l0 = tr_read<v_rd_off(D0, 0, 0)>(vb), h0 = tr_read<v_rd_off(D0, 0, 1)>(vb), l1 = tr_read<v_rd_off(D0, 1, 0)>(vb), h1 = tr_read<v_rd_off(D0, 1, 1)>(vb);
  const s16x4 l2 = tr_read<v_rd_off(D0, 2, 0)>(vb), h2 = tr_read<v_rd_off(D0, 2, 1)>(vb), l3 = tr_read<v_rd_off(D0, 3, 0)>(vb), h3 = tr_read<v_rd_off(D0, 3, 1)>(vb);
  asm volatile("s_waitcnt lgkmcnt(0)" ::: "memory"); SBAR();
#define PK(L, H) (bf16x8){L[0], L[1], L[2], L[3], H[0], H[1], H[2], H[3]}
  od = __builtin_amdgcn_mfma_f32_32x32x16_bf16(pa0, PK(l0, h0), od, 0, 0, 0);
  od = __builtin_amdgcn_mfma_f32_32x32x16_bf16(pa1, PK(l1, h1), od, 0, 0, 0);
  od = __builtin_amdgcn_mfma_f32_32x32x16_bf16(pa2, PK(l2, h2), od, 0, 0, 0);
  od = __builtin_amdgcn_mfma_f32_32x32x16_bf16(pa3, PK(l3, h3), od, 0, 0, 0);
#undef PK
}
__device__ __forceinline__ void pv_d0(f32x16* o, int vb, bf16x8 pa0, bf16x8 pa1, bf16x8 pa2, bf16x8 pa3) {
  pv_one<0>(o[0], vb, pa0, pa1, pa2, pa3); pv_one<1>(o[1], vb, pa0, pa1, pa2, pa3);
}
__device__ __forceinline__ void attn_unit(const bf16_t* __restrict__ Qb, const bf16_t* __restrict__ KVh, const bf16_t* __restrict__ KPEb, const f32x2* __restrict__ csq, bf16_t* __restrict__ Ob, char* lds) {
  const int tid = opaque_tid(), wid = tid >> 6, lane = tid & 63, r32 = lane & 31, hi = lane >> 5;
  char* V_lds = lds; char* K_lds = lds + NSLOT * SHM_V;
  float* ws = (float*)(lds + NSLOT * SHM_V + NSLOT * SHM_K) + wid * 64; float* li_l = ws; float* al_l = ws + 32;
  float m_reg = 0.f, l_reg = 0; f32x16 o[2] = {}; bf16x8 qr[6]; f32x16 negm = {};
  const bf16_t* Qw = Qb + (long)(wid * QBLK + r32) * 768 + hi * 8;
#pragma unroll
  for (int d0 = 0; d0 < 6; ++d0) qr[d0] = *reinterpret_cast<const bf16x8*>(Qw + d0 * 16);
#pragma unroll
  for (int d0 = 4; d0 < 6; ++d0) {
    const f32x2* c = csq + (wid * QBLK + r32) * 16 + 8 * (d0 - 4) + 4 * hi;
    float f[8], g[8]; unpack8(__builtin_bit_cast(u32x4, qr[d0]), f);
#pragma unroll
    for (int p = 0; p < 4; ++p) { const f32x2 cc = c[p]; g[2 * p] = f[2 * p] * cc.x - f[2 * p + 1] * cc.y; g[2 * p + 1] = f[2 * p] * cc.y + f[2 * p + 1] * cc.x; }
    qr[d0] = __builtin_bit_cast(bf16x8, pack8(g));
  }
  const int kc0 = tid, kc1 = 512 + (tid & 255);
  const int kd0 = KSWZ(kc0 / 12, (kc0 % 12) * 16), kd1 = KSWZ(kc1 / 12, (kc1 % 12) * 16), vd0 = v_st(tid >> 3, (tid & 7) * 8);
  const int cc0 = kc0 % 12, cc1 = kc1 % 12;
  const bf16_t* ksrc0 = cc0 < 8 ? KVh + (long)(kc0 / 12) * 1024 + cc0 * 8 : KPEb + (long)(kc0 / 12) * ROPE + (cc0 - 8) * 8;
  const bf16_t* ksrc1 = cc1 < 8 ? KVh + (long)(kc1 / 12) * 1024 + cc1 * 8 : KPEb + (long)(kc1 / 12) * ROPE + (cc1 - 8) * 8;
  const int kstr0 = cc0 < 8 ? 1024 : ROPE, kstr1 = cc1 < 8 ? 1024 : ROPE;
  const bf16_t* vsrc = KVh + 64 + (long)(tid >> 3) * 1024 + (tid & 7) * 8;
  const bool k1w = tid < 256;
  const int vb0 = (int)(uintptr_t)V_lds + v_rd_base(lane);
  struct { bf16x8 vs0, ks0, ks1; } sr_[2];
#define SLOAD(i, k0) do { sr_[i].vs0 = *reinterpret_cast<const bf16x8*>(vsrc + (long)(k0) * 1024); \
    sr_[i].ks0 = *reinterpret_cast<const bf16x8*>(ksrc0 + (long)(k0) * kstr0); sr_[i].ks1 = *reinterpret_cast<const bf16x8*>(ksrc1 + (long)(k0) * kstr1); } while (0)
#define SWRITE(b, i) do { *(bf16x8*)(V_lds + (b) * SHM_V + vd0) = sr_[i].vs0; *(bf16x8*)(K_lds + (b) * SHM_K + kd0) = sr_[i].ks0; \
    if (k1w) *(bf16x8*)(K_lds + (b) * SHM_K + kd1) = sr_[i].ks1; } while (0)
#define SWAIT() asm volatile("s_waitcnt vmcnt(3)" ::: "memory")
#define RESC(a) do { if (__any((a) < 1.f)) { if (hi == 0) al_l[r32] = (a); asm volatile("s_waitcnt lgkmcnt(0)" ::: "memory"); \
    _Pragma("unroll") for (int d = 0; d < 2; ++d) _Pragma("unroll") for (int r = 0; r < 16; ++r) o[d][r] *= al_l[crow(r, hi)]; } } while (0)
  f32x16 pA0, pA1, pB0, pB1; float alA, alB; bf16x8 pa0, pa1, pa2, pa3; constexpr int NT = SEQ / KVBLK;
  constexpr int SE = 0, SO = 1;
#define LBAR() asm volatile("s_waitcnt lgkmcnt(0)\n\ts_barrier" ::: "memory")
  SLOAD(SE, 0); asm volatile("s_waitcnt vmcnt(0)" ::: "memory"); SWRITE(0, SE); LBAR();
  qkt(pA0, pA1, K_lds, qr, negm, r32, hi); partialSM<true>(pA0, pA1, m_reg, negm, alA);
  SLOAD(SO, KVBLK); SLOAD(SE, 2 * KVBLK);
  SWAIT(); SWRITE(1, SO); LBAR();
  int s_prev = 0, s_cur = 1, s_next = 2;
#define ROT() do { s_prev = s_cur; s_cur = s_next; s_next = (s_next == NSLOT - 1) ? 0 : s_next + 1; } while (0)
  for (int j = 1; j + 1 < NT; j += 2) {
    SBAR(); qkt(pB0, pB1, K_lds + s_cur * SHM_K, qr, negm, r32, hi);
    finishSM(pA0, pA1, alA, l_reg, pa0, pa1, pa2, pa3); SBAR();
    SLOAD(SO, (j + 2) * KVBLK); SBAR();
    pv_d0(o, vb0 + s_prev * SHM_V, pa0, pa1, pa2, pa3); partialSM<false>(pB0, pB1, m_reg, negm, alB);
    SWAIT(); SWRITE(s_next, SE);
    RESC(alB); LBAR(); ROT();
    SBAR(); qkt(pA0, pA1, K_lds + s_cur * SHM_K, qr, negm, r32, hi);
    finishSM(pB0, pB1, alB, l_reg, pa0, pa1, pa2, pa3); SBAR();
    if (j + 3 < NT) SLOAD(SE, (j + 3) * KVBLK); SBAR();
    pv_d0(o, vb0 + s_prev * SHM_V, pa0, pa1, pa2, pa3); partialSM<false>(pA0, pA1, m_reg, negm, alA);
    SWAIT(); SWRITE(s_next, SO);
    RESC(alA); LBAR(); ROT();
  }
  SBAR(); qkt(pB0, pB1, K_lds + s_cur * SHM_K, qr, negm, r32, hi);
  finishSM(pA0, pA1, alA, l_reg, pa0, pa1, pa2, pa3); SBAR();
  pv_d0(o, vb0 + s_prev * SHM_V, pa0, pa1, pa2, pa3); partialSM<false>(pB0, pB1, m_reg, negm, alB);
  RESC(alB);
  finishSM(pB0, pB1, alB, l_reg, pa0, pa1, pa2, pa3); SBAR();
  pv_d0(o, vb0 + s_cur * SHM_V, pa0, pa1, pa2, pa3);
#undef ROT
#undef LBAR
  if (hi == 0) li_l[r32] = l_reg; asm volatile("s_waitcnt lgkmcnt(0)" ::: "memory");
  float rli[16];
#pragma unroll
  for (int r = 0; r < 16; ++r) rli[r] = __builtin_amdgcn_rcpf(li_l[crow(r, hi)]);
  bf16_t* Ow = Ob + (long)(wid * QBLK) * 1024;
#pragma unroll
  for (int r = 0; r < 16; ++r) { int orow = crow(r, hi);
#pragma unroll
    for (int d0 = 0; d0 < 2; ++d0) Ow[(long)orow * 1024 + d0 * 32 + r32] = (bf16_t)f2bf(o[d0][r] * rli[r]); }
  __syncthreads();
#undef SLOAD
#undef SWRITE
#undef SWAIT
#undef RESC
}
#undef SBAR
}

__device__ __forceinline__ void attn_phase(const Ctx& C, const bf16_t* Q, const bf16_t* KV, const bf16_t* KPE, const f32x2* cs, bf16_t* O) {
#if FAST_ATTN
    const int v = (C.nblk % 8 == 0) ? (C.blk % 8) * (C.nblk / 8) + C.blk / 8 : C.blk;
    for (int u = v; u < NB * NH * (SEQ / 256); u += C.nblk) {
        const int bh = u >> 3, qb = u & 7, b = bh >> 3, h = bh & 7;
        att::attn_unit(Q + ((size_t)b * SEQ + qb * 256) * 768 + h * DQK, KV + (size_t)b * SEQ * 1024 + h * 128, KPE + (size_t)b * SEQ * ROPE, cs + qb * 256 * 16,
                       O + ((size_t)b * SEQ + qb * 256) * 1024 + h * VH, (char*)C.lds);
    }
#else
    for (int it = C.blk; it < NB * NH * (SEQ / NTHR); it += C.nblk) {
        const int bh = it >> 2, q = (it & 3) * NTHR + C.tid, b = bh >> 3, h = bh & 7;
        float qv[DQK], o[VH];
        const bf16_t* qp = Q + ((size_t)b * SEQ + q) * 768 + h * DQK;
#pragma unroll
        for (int d = 0; d < DQK; d += 8) unpack8(*(const u32x4*)(qp + d), qv + d);
#pragma unroll
        for (int i = 0; i < 16; ++i) { const f32x2 cc = cs[q * 16 + i]; const float x0 = bf2f(f2bf(qv[64 + 2 * i])), x1 = qv[65 + 2 * i]; qv[64 + 2 * i] = x0 * cc.x - x1 * cc.y; qv[65 + 2 * i] = x0 * cc.y + x1 * cc.x; }
#pragma unroll
        for (int d = 0; d < VH; ++d) o[d] = 0.f;
        float m = -1e30f, l = 0.f;
        for (int k = 0; k < SEQ; ++k) {
            const bf16_t* kvp = KV + ((size_t)b * SEQ + k) * 1024 + h * 128; const bf16_t* pep = KPE + ((size_t)b * SEQ + k) * ROPE; const bf16_t* vp = kvp + 64;
            float s = 0.f;
#pragma unroll
            for (int d = 0; d < DQK; d += 8) { float kf[8]; unpack8(*(const u32x4*)(d < 64 ? kvp + d : pep + (d - 64)), kf);
#pragma unroll
                for (int e = 0; e < 8; ++e) s += qv[d + e] * kf[e]; }
            const float mn = fmaxf(m, s), al = exp2f(m - mn), p = exp2f(s - mn);
            l = l * al + p; m = mn;
#pragma unroll
            for (int d = 0; d < VH; d += 8) { float vf[8]; unpack8(*(const u32x4*)(vp + d), vf);
#pragma unroll
                for (int e = 0; e < 8; ++e) o[d + e] = o[d + e] * al + p * vf[e]; }
        }
        const float rl = 1.0f / l;
        bf16_t* op = O + ((size_t)b * SEQ + q) * 1024 + h * VH;
#pragma unroll
        for (int d = 0; d < VH; d += 8) { float t[8];
#pragma unroll
            for (int e = 0; e < 8; ++e) t[e] = o[d + e] * rl;
            *(u32x4*)(op + d) = pack8(t); }
    }
#endif
}

constexpr int HY_CS = 8256;
__device__ __forceinline__ void hyena_phase(const Ctx& C, const bf16_t* tapsR  , const bf16_t* zT, bf16_t* yT) {
#if FAST_HYENA
    const int lane = C.lane, r = lane & 31, h = lane >> 5, w = C.wave;
    const int kc = (7 - r) & 7;
    const int lane_base = kc * HY_CS + 2 * (2047 - r - kc + 32 * h);
    for (int c = C.blk; c < DHY; c += C.nblk) {
        __syncthreads();
        const bf16_t* R = tapsR + (size_t)c * 4096;
        for (int idx = C.tid; idx < 4096; idx += NTHR) { const unsigned short v = R[idx];
#pragma unroll
            for (int k = 0; k < 8; ++k) { const int m = idx - k; if (m >= 0) *(LAS unsigned short*)(C.lds + k * HY_CS + 2 * m) = v; } }
        __syncthreads();
        f32x16 acc[8];
#pragma unroll
        for (int i = 0; i < 8; ++i) acc[i] = f32x16{};
        const bf16_t* zrow = zT + ((size_t)c * NB + r) * SEQ + 32 * h;
        bf16x8 zf[4], zn[4];
#pragma unroll
        for (int k = 0; k < 4; ++k) zf[k] = *(const bf16x8*)(zrow + 8 * k);
        for (int S0 = 0; S0 < SEQ; S0 += 64) {
            const int S1 = (S0 + 64 < SEQ) ? S0 + 64 : S0;
#pragma unroll
            for (int k = 0; k < 4; ++k) zn[k] = *(const bf16x8*)(zrow + S1 + 8 * k);
            const LAS unsigned char* tb = C.lds + (lane_base + 2 * (S0 - 256 * w - 224));
#pragma unroll
            for (int k = 0; k < 4; ++k)
#pragma unroll
                for (int i = 0; i < 8; ++i) {
                    const bf16x8 tf = *(const LAS bf16x8*)(tb + 64 * (7 - i) + 16 * k);
                    acc[i] = __builtin_amdgcn_mfma_f32_32x32x16_bf16(zf[k], tf, acc[i], 0, 0, 0);
                }
#pragma unroll
            for (int k = 0; k < 4; ++k) zf[k] = zn[k];
        }
#pragma unroll
        for (int i = 0; i < 8; ++i)
#pragma unroll
            for (int q = 0; q < 16; ++q) { const int b = (q & 3) + 8 * (q >> 2) + 4 * h;
                yT[((size_t)c * NB + b) * SEQ + 256 * w + 32 * i + r] = (bf16_t)f2bf(acc[i][q]); }
    }
#else
    LAS float* Rf = (LAS float*)C.lds; LAS float* zf = (LAS float*)(C.lds + 16384);
    for (int it = C.blk; it < DHY * NB; it += C.nblk) {
        const int c = it >> 5, b = it & 31;
        __syncthreads();
        for (int i = C.tid; i < 4096; i += NTHR) Rf[i] = bf2f(tapsR[(size_t)c * 4096 + i]);
        for (int i = C.tid; i < SEQ; i += NTHR) zf[i] = bf2f(zT[((size_t)c * NB + b) * SEQ + i]);
        __syncthreads();
        float y[4] = {0.f, 0.f, 0.f, 0.f};
        for (int s = 0; s < SEQ; ++s) { const float z = zf[s];
#pragma unroll
            for (int k = 0; k < 4; ++k) y[k] += Rf[2047 - (C.tid + NTHR * k) + s] * z; }
#pragma unroll
        for (int k = 0; k < 4; ++k) yT[((size_t)c * NB + b) * SEQ + C.tid + NTHR * k] = (bf16_t)f2bf(y[k]);
    }
#endif
}

__global__ void __launch_bounds__(NTHR) mega_fwd(Params P) {
    extern __shared__ __attribute__((aligned(16))) unsigned char lds_raw[];
    cg::grid_group grid = cg::this_grid();
    Ctx C; C.tid = threadIdx.x; C.lane = C.tid & 63; C.wave = __builtin_amdgcn_readfirstlane(C.tid >> 6); C.blk = blockIdx.x; C.nblk = gridDim.x;
    C.lds = (LAS unsigned char*)lds_raw;
    unsigned char* ws = P.ws;
    bf16_t* Hb = (bf16_t*)(ws + WS_H); bf16_t* LAT = (bf16_t*)(ws + WS_LAT); bf16_t* HYIN = (bf16_t*)(ws + WS_HYIN); bf16_t* GATES = (bf16_t*)(ws + WS_GATES);
    bf16_t* Qb = (bf16_t*)(ws + WS_Q); bf16_t* KVb = (bf16_t*)(ws + WS_KV); bf16_t* KPE = (bf16_t*)(ws + WS_KPE); bf16_t* Ob = (bf16_t*)(ws + WS_O);
    bf16_t* ZT = (bf16_t*)(ws + WS_ZT); bf16_t* X0C = (bf16_t*)(ws + WS_X0C); bf16_t* YT = (bf16_t*)(ws + WS_YT);
    bf16_t* MERGED = (bf16_t*)(ws + WS_MERGED); bf16_t* ACT = (bf16_t*)(ws + WS_ACT);
    const f32x2* CS = (const f32x2*)(ws + WS_ROPE); float* SSQ = (float*)(ws + WS_SSQ);
    float* out = P.out;
#define XB ((bf16_t*)P.out)

#define PH_BEGIN() do { C.tid = opaque_tid(); C.lane = C.tid & 63; C.wave = __builtin_amdgcn_readfirstlane(C.tid >> 6); } while (0)
    volatile LAS unsigned* bst = (volatile LAS unsigned*)(C.lds + LDS_CTL);
    if (C.tid < 4) bst[C.tid] = 0u;
    if (C.blk == 0) for (int i = C.tid; i < XCD_BAR_WORDS; i += NTHR) ((unsigned*)(ws + WS_BAR))[i] = 0u;
    __syncthreads();
    XcdBarrier xbar; bool xposted = false;
#define GRID_SYNC() do { if (!xposted) { grid.sync(); xbar = xcd_barrier_post((unsigned*)(ws + WS_BAR), bst); xposted = true; } else xcd_barrier(xbar); } while (0)
    for (int rep = 0; rep < (DBL_PHASE == 7 ? 2 : 1); ++rep) prologue(P, C);
    for (int l = 0; l < 2; ++l) {
        const unsigned char* wl = ws + WS_W + (size_t)l * W_LAYER;
        const bf16_t* WinT = (const bf16_t*)(wl + WO_IN); const bf16_t* WqT = (const bf16_t*)(wl + WO_Q); const bf16_t* WkvT = (const bf16_t*)(wl + WO_KV);
        const bf16_t* WaT = (const bf16_t*)(wl + WO_A); const bf16_t* WhT = (const bf16_t*)(wl + WO_H); const bf16_t* WoT = (const bf16_t*)(wl + WO_O);
        const bf16_t* WguT = (const bf16_t*)(wl + WO_GU); const bf16_t* WdT = (const bf16_t*)(wl + WO_D);
        const float* xin = l == 0 ? P.in[0] : out;
        if (l == 0) { xcast_rows(C, P.in[0], XB, SSQ); GRID_SYNC(); PH_BEGIN(); }
        for (int rep = 0; rep < (DBL_PHASE == 3 ? 2 : 1); ++rep) run_gemm<true>(C, XB, DM, WinT, 4096, DM, FInProj{LAT, HYIN, GATES, SSQ + (size_t)(2 * l) * MTOK * 4});
        GRID_SYNC(); PH_BEGIN();
        for (int rep = 0; rep < (DBL_PHASE == 5 ? 2 : 1); ++rep) {
        lat_rows(C, LAT, CS, KPE);
        PH_BEGIN();
        hy_pre(C, HYIN, P.in[9] + l * 3 * 1536, P.in[10] + l * 1536, X0C, ZT); }
        GRID_SYNC(); PH_BEGIN();
        for (int rep = 0; rep < (DBL_PHASE == 6 ? 2 : 1); ++rep) {
        run_gemm<true>(C, LAT, 512, WqT, 768, 256, FPlain{Qb, 768});
        PH_BEGIN();
        run_gemm<true>(C, LAT + 256, 512, WkvT, 1024, 256, FPlain{KVb, 1024}); }
        GRID_SYNC(); PH_BEGIN();
        for (int rep = 0; rep < (DBL_PHASE == 1 ? 2 : 1); ++rep) hyena_phase(C, (const bf16_t*)(ws + WS_TAPS) + (size_t)l * DHY * 4096, ZT, YT);
        __syncthreads(); PH_BEGIN();
        for (int rep = 0; rep < (DBL_PHASE == 2 ? 2 : 1); ++rep) attn_phase(C, Qb, KVb, KPE, CS, Ob);
        GRID_SYNC(); PH_BEGIN();
        hy_post(C, YT, X0C, Ob);
        GRID_SYNC(); PH_BEGIN();
        run_gemm_epi(C, Ob, 1024, (const bf16_t*)(ws + WS_WM + (size_t)l * WM_LAYER), 2048, 1024, EpiMerge2{GATES, MERGED});
        GRID_SYNC(); PH_BEGIN();
        run_gemm_epi(C, MERGED, DM, WoT, DM, DM, EpiResidB{XB, SSQ + (size_t)(2 * l + 1) * MTOK * 4, (LAS float*)(C.lds + LDS_TAB)});
        GRID_SYNC(); PH_BEGIN();
        for (int rep = 0; rep < (DBL_PHASE == 4 ? 2 : 1); ++rep) run_gemm<true>(C, XB, DM, WguT, 2 * DFF, DM, FSwiglu{ACT, SSQ + (size_t)(2 * l + 1) * MTOK * 4});
        GRID_SYNC(); PH_BEGIN();
        if (l == 0) run_gemm_epi(C, ACT, DFF, WdT, DM, DFF, EpiResidB{XB, SSQ + (size_t)2 * MTOK * 4, (LAS float*)(C.lds + LDS_TAB)});
        else run_gemm_epi(C, ACT, DFF, WdT, DM, DFF, EpiResidF{XB, (bf16_t*)(ws + WS_XF)});
        GRID_SYNC(); PH_BEGIN();
    }
    if (DBL_PHASE == 9) { for (int rep = 0; rep < 20; ++rep) GRID_SYNC(); }
    rmsnorm_final(C, (const bf16_t*)(ws + WS_XF), out, P.in[28]);
}

extern "C" void kernel_launch(void* const* d_in, const int* in_sizes, int n_in, void* d_out, int out_size, void* d_ws, size_t ws_size, hipStream_t stream) {
    static int grid = 0;
    if (grid == 0) {
        if (n_in != 29 || out_size != MTOK * DM || ws_size < WS_END) { fprintf(stderr, "kernel_launch: unexpected shapes (n_in %d out %d ws %zu)\n", n_in, out_size, ws_size); grid = -1; return; }
        int dev = 0, cus = 0, per_cu = 0;
        (void)hipGetDevice(&dev); (void)hipDeviceGetAttribute(&cus, hipDeviceAttributeMultiprocessorCount, dev);
        if (hipFuncSetAttribute((const void*)mega_fwd, hipFuncAttributeMaxDynamicSharedMemorySize, LDS_BYTES) != hipSuccess) { fprintf(stderr, "kernel_launch: hipFuncSetAttribute failed\n"); }
        if (hipOccupancyMaxActiveBlocksPerMultiprocessor(&per_cu, (const void*)mega_fwd, NTHR, LDS_BYTES) != hipSuccess || per_cu < 1) { fprintf(stderr, "kernel_launch: occupancy query says %d\n", per_cu); per_cu = 1; }
        (void)hipGetLastError();
        grid = cus > 0 ? cus : 256;
    }
    if (grid < 0) return;
    Params p{};
    for (int i = 0; i < 29; ++i) p.in[i] = (const float*)d_in[i];
    p.out = (float*)d_out; p.ws = (unsigned char*)d_ws;
    void* args[] = {&p};
    hipError_t e = hipLaunchCooperativeKernel((const void*)mega_fwd, dim3(grid), dim3(NTHR), args, LDS_BYTES, stream);
    if (e != hipSuccess) fprintf(stderr, "kernel_launch: cooperative launch failed: %s (grid %d)\n", hipGetErrorString(e), grid);
}
```

```cpp
#include <hip/hip_runtime.h>
#include <hip/hip_cooperative_groups.h>
#include <cstdio>
#include <cstdint>
namespace cg = cooperative_groups;

#ifndef FAST_GEMM
#define FAST_GEMM 1
#endif
#ifndef FAST_ATTN
#define FAST_ATTN 1
#endif
#ifndef FAST_HYENA
#define FAST_HYENA 1
#endif

#ifndef DBL_PHASE
#define DBL_PHASE 0
#endif
#define LAS __attribute__((address_space(3)))
typedef unsigned short bf16_t;
typedef short bf16x8 __attribute__((ext_vector_type(8)));
typedef short s16x4 __attribute__((ext_vector_type(4)));
typedef float f32x4 __attribute__((ext_vector_type(4)));
typedef float f32x2 __attribute__((ext_vector_type(2)));
typedef float f32x16 __attribute__((ext_vector_type(16)));
typedef unsigned u32x4 __attribute__((ext_vector_type(4)));
typedef unsigned u32x2 __attribute__((ext_vector_type(2)));

constexpr int DM = 1024, NB = 32, SEQ = 2048, MTOK = NB * SEQ, NH = 8, QL = 256, KVL = 128, NOPE = 64, ROPE = 32, VH = 64, DHY = 512, DFF = 2816, INC = 4000;
constexpr int DQK = NOPE + ROPE;
constexpr float EPS = 1e-6f;
namespace att { constexpr float QSCALE = 0.10206207261596575f * 1.4426950408889634f; }
constexpr int NTHR = 512, NWAVE = 8;
constexpr int LDS_BYTES = 136192;
constexpr int LDS_CTL = 131072, LDS_TAB = 131072 + 1024;

constexpr size_t MiB = 1u << 20;
constexpr size_t WS_BAR = 0;
constexpr size_t WS_ROPE = 1 * MiB;
constexpr size_t WS_SSQ = 952 * MiB;
constexpr size_t WS_TAPS = 4 * MiB;
constexpr size_t WS_W = 12 * MiB, W_LAYER = 30 * MiB;
constexpr size_t WO_IN = 0, WO_Q = 8 * MiB, WO_KV = WO_Q + 384 * 1024, WO_A = WO_KV + 512 * 1024, WO_H = WO_A + 1 * MiB, WO_O = WO_H + 1 * MiB,
                 WO_GU = WO_O + 2 * MiB, WO_D = WO_GU + 11 * MiB;
constexpr size_t WS_H = 72 * MiB;
constexpr size_t WS_ZT = WS_H, WS_X0C = WS_H + 64 * MiB;
constexpr size_t WS_LAT = 200 * MiB;
constexpr size_t WS_HYIN = 264 * MiB;
constexpr size_t WS_O = WS_HYIN, WS_YT = WS_HYIN + 128 * MiB;
constexpr size_t WS_GATES = 456 * MiB;
constexpr size_t WS_Q = 712 * MiB, WS_KV = 808 * MiB, WS_KPE = 936 * MiB;
constexpr size_t WS_MERGED = WS_Q;
constexpr size_t WS_ACT = WS_LAT;
constexpr size_t WS_WM = 944 * MiB, WM_LAYER = 4 * MiB;
constexpr size_t WS_XF = 552 * MiB;
constexpr size_t WS_END = 968 * MiB;

struct Params { const float* in[29]; float* out; unsigned char* ws; };

__device__ __forceinline__ int opaque_tid() { int t = threadIdx.x; asm volatile("" : "+v"(t)); return t; }
__device__ __forceinline__ float bf2f(unsigned v) { return __uint_as_float(v << 16); }
__device__ __forceinline__ unsigned f2bf(float f) { unsigned u = __float_as_uint(f); return (u + 0x7fffu + ((u >> 16) & 1u)) >> 16; }
__device__ __forceinline__ unsigned pk2(float lo, float hi) { return f2bf(lo) | (f2bf(hi) << 16); }
__device__ __forceinline__ unsigned cvt_pk_bf16(float lo, float hi) { unsigned r; asm volatile("v_cvt_pk_bf16_f32 %0, %1, %2" : "=v"(r) : "v"(lo), "v"(hi)); return r; }
__device__ __forceinline__ float fast_sigmoid(float x) { return __builtin_amdgcn_rcpf(1.0f + __expf(-x)); }
__device__ __forceinline__ void unpack8(u32x4 w, float* f) {
    f[0] = __uint_as_float(w.x << 16); f[1] = __uint_as_float(w.x & 0xffff0000u); f[2] = __uint_as_float(w.y << 16); f[3] = __uint_as_float(w.y & 0xffff0000u);
    f[4] = __uint_as_float(w.z << 16); f[5] = __uint_as_float(w.z & 0xffff0000u); f[6] = __uint_as_float(w.w << 16); f[7] = __uint_as_float(w.w & 0xffff0000u);
}
__device__ __forceinline__ u32x4 pack8(const float* f) { u32x4 w; w.x = cvt_pk_bf16(f[0], f[1]); w.y = cvt_pk_bf16(f[2], f[3]); w.z = cvt_pk_bf16(f[4], f[5]); w.w = cvt_pk_bf16(f[6], f[7]); return w; }

namespace pg8 {
#define PG8_LAS __attribute__((address_space(3)))
constexpr int BM = 256, BK = 64, HALF = 128, HTB = HALF * BK * 2  , STAGE_BYTES = 8 * HTB, NXCD = 8, WGM = 8;
__host__ __device__ __forceinline__ int lds_byte(int r, int c) { const int st = (r >> 4) * 2 + (c >> 5), rr = r & 15, cc = c & 31, ob = rr * 64 + cc * 2; return st * 1024 + (ob ^ (((ob >> 9) & 1) << 5)); }
__host__ __device__ __forceinline__ void stage_rc(int b, int& R, int& C) { const int st = b / 1024, sb = b % 1024, swz = sb ^ (((sb >> 9) & 1) << 5); R = (st >> 1) * 16 + swz / 64; C = (st & 1) * 32 + (swz % 64) / 2; }
__host__ __device__ __forceinline__ int perm32(int rho) { const int n = rho >> 4, i = rho & 15; return 8 * (i >> 2) + 4 * n + (i & 3); }

struct Unit { int pm, pn; };
struct Gemm { const bf16_t* A; const bf16_t* Bt; int M, N, K, lda; };

struct StaticOrder {
    int nM, nN, nwg, G, c;
    __host__ __device__ void init(int M, int N, int G_, int c_) { nM = M / BM; nN = N / BM; nwg = nM * nN; G = G_; c = c_; }
    __host__ __device__ bool next(int i, Unit& u) const {
        const long L = (long)i * G + c; if (L >= nwg) return false;
        int wgid = (int)L; { const int q = nwg / NXCD, r = nwg % NXCD, xcd = wgid % NXCD, off = wgid / NXCD; wgid = (xcd < r ? xcd * (q + 1) : r * (q + 1) + (xcd - r) * q) + off; }
        const int nig = WGM * nN, gid = wgid / nig, fm = gid * WGM, gsz = (nM - fm) < WGM ? (nM - fm) : WGM;
        u.pm = fm + ((wgid % nig) % gsz); u.pn = (wgid % nig) / gsz; return true;
    }
    __device__ __forceinline__ void a_ready(const Unit&) const {}
    __device__ __forceinline__ void done(const Unit&) const {}
};

template <class F> struct Epi8 {
    static constexpr bool PERM = true, AFTER_DRAIN = false, HALFSKIP = false; F f;
    __device__ __forceinline__ void operator()(const f32x4 (&acc)[2][2][4][2], const Unit& u, int wr, int wc, int fr, int fq) const {
        float rs[2][4];
#pragma unroll
        for (int ai = 0; ai < 2; ++ai)
#pragma unroll
            for (int m = 0; m < 4; ++m) rs[ai][m] = f.rowscale(u.pm * BM + ai * HALF + wr * 64 + m * 16 + fr);
#pragma unroll
        for (int ai = 0; ai < 2; ++ai) {
#pragma unroll
            for (int m = 0; m < 4; ++m) { const int row = u.pm * BM + ai * HALF + wr * 64 + m * 16 + fr;
#pragma unroll
                for (int bj = 0; bj < 2; ++bj) f(row, u.pn * BM + bj * HALF + wc * 32 + 8 * fq, acc[ai][bj][m][0] * rs[ai][m], acc[ai][bj][m][1] * rs[ai][m]); }
            asm volatile("" ::: "memory"); }
    }
};
template <class F> struct Epi4 {
    static constexpr bool PERM = false, AFTER_DRAIN = false, HALFSKIP = false; F f;
    __device__ __forceinline__ void operator()(const f32x4 (&acc)[2][2][4][2], const Unit& u, int wr, int wc, int fr, int fq) const {
#pragma unroll
        for (int ai = 0; ai < 2; ++ai)
#pragma unroll
            for (int m = 0; m < 4; ++m) { const int row = u.pm * BM + ai * HALF + wr * 64 + m * 16 + fr;
#pragma unroll
                for (int bj = 0; bj < 2; ++bj)
#pragma unroll
                    for (int n = 0; n < 2; ++n) f(row, u.pn * BM + bj * HALF + wc * 32 + 16 * n + 4 * fq, acc[ai][bj][m][n]);
                asm volatile("" ::: "memory"); }
    }
};

template <class Epi, class Sched>
__device__ __forceinline__ void gemm_simple(const Gemm g, const Sched& S, const Epi& E) {
    const int tid = opaque_tid(), wid = tid >> 6, lane = tid & 63, wr = wid >> 2, wc = wid & 3, fr = lane & 15, fq = lane >> 4;
    Unit u;
    for (int i = 0; S.next(i, u); ++i) {
        f32x4 acc[2][2][4][2];
#pragma unroll
        for (int a = 0; a < 2; ++a)
#pragma unroll
            for (int b = 0; b < 2; ++b)
#pragma unroll
                for (int m = 0; m < 4; ++m)
#pragma unroll
                    for (int n = 0; n < 2; ++n) acc[a][b][m][n] = (f32x4){0.f, 0.f, 0.f, 0.f};
        const bf16_t* Ab = g.A + (size_t)(u.pm * BM + wr * 64 + fr) * g.lda + fq * 8;
        const bf16_t* Bb = g.Bt + (size_t)(u.pn * BM + wc * 32) * g.K + fq * 8;
#pragma unroll 1
        for (int k0 = 0; k0 < g.K; k0 += 32) {
            bf16x8 Bf[2][2];
#pragma unroll
            for (int bj = 0; bj < 2; ++bj)
#pragma unroll
                for (int n = 0; n < 2; ++n) { const int rho = 16 * n + fr; const int wrow = bj * HALF + (Epi::PERM ? perm32(rho) : rho);
                    Bf[bj][n] = *(const bf16x8*)(Bb + (size_t)wrow * g.K + k0); }
#pragma unroll
            for (int ai = 0; ai < 2; ++ai)
#pragma unroll
                for (int m = 0; m < 4; ++m) { const bf16x8 Af = *(const bf16x8*)(Ab + (size_t)(ai * HALF + m * 16) * g.lda + k0);
#pragma unroll
                    for (int bj = 0; bj < 2; ++bj)
#pragma unroll
                        for (int n = 0; n < 2; ++n) acc[ai][bj][m][n] = __builtin_amdgcn_mfma_f32_16x16x32_bf16(Bf[bj][n], Af, acc[ai][bj][m][n], 0, 0, 0); }
        }
        E(acc, u, wr, wc, fr, fq);
    }
}

template <class Epi, class Sched, bool ALIGN_EPI = false, bool SP2 = false>
__device__ __forceinline__ void gemm_phase(PG8_LAS unsigned char* lds, const Gemm g, const Sched& S, const Epi& E) {
    const int tid = opaque_tid(), wid = __builtin_amdgcn_readfirstlane(tid >> 6), lane = tid & 63, wr = wid >> 2, wc = wid & 3, fr = lane & 15, fq = lane >> 4;
    int Kop = g.K; asm volatile("" : "+s"(Kop));
    const int K = Kop, nt = K / BK;
    unsigned voffA[2], voffB[2];
#pragma unroll
    for (int i = 0; i < 2; ++i) { int R, C; stage_rc(tid * 16 + i * 8192, R, C); const int Rb = Epi::PERM ? ((R & ~31) + perm32(R & 31)) : R;
        voffA[i] = (unsigned)(R * g.lda + C) * 2u; voffB[i] = (unsigned)(Rb * K + C) * 2u; }
    const size_t kstep = (size_t)(BK * 2);
    const size_t hstepA = (size_t)HALF * g.lda * 2, hstepB = (size_t)HALF * K * 2;
    const size_t tstepA = 2 * hstepA, tstepB = 2 * hstepB;
    const unsigned ldsw = (unsigned)wid * 1024u;
    const int aoff = lds_byte(wr * 64 + fr, fq * 8), boff = lds_byte(wc * 32 + fr, fq * 8);
#define PG8_SA(b, h) (((b) * 2 + (h)) * HTB)
#define PG8_SB(b, h) ((4 + (b) * 2 + (h)) * HTB)
#define PG8_STAGE(bufoff, gbase, voff) do { _Pragma("unroll") for (int _i = 0; _i < 2; ++_i) \
        __builtin_amdgcn_global_load_lds((const unsigned*)((const char*)(gbase) + (voff)[_i]), (PG8_LAS unsigned*)(lds + (bufoff) + ldsw + _i * 8192), 16, 0, 0); } while (0)
#define PG8_LDA(dst, b, h) do { _Pragma("unroll") for (int m = 0; m < 4; ++m) _Pragma("unroll") for (int k = 0; k < 2; ++k) dst[m][k] = *(const PG8_LAS bf16x8*)(lds + PG8_SA(b, h) + aoff + m * 2048 + k * 1024); } while (0)
#define PG8_LDB(dst, b, h) do { _Pragma("unroll") for (int n = 0; n < 2; ++n) _Pragma("unroll") for (int k = 0; k < 2; ++k) dst[n][k] = *(const PG8_LAS bf16x8*)(lds + PG8_SB(b, h) + boff + n * 2048 + k * 1024); } while (0)
#define PG8_MMA(ai, bj, At, Bt) do { __builtin_amdgcn_s_setprio(1); _Pragma("unroll") for (int m = 0; m < 4; ++m) _Pragma("unroll") for (int n = 0; n < 2; ++n) _Pragma("unroll") for (int k = 0; k < 2; ++k) \
        acc[ai][bj][m][n] = __builtin_amdgcn_mfma_f32_16x16x32_bf16(Bt[n][k], At[m][k], acc[ai][bj][m][n], 0, 0, 0); __builtin_amdgcn_s_setprio(0); } while (0)
#define PG8_WAIT_V(n) asm volatile("s_waitcnt vmcnt(" #n ")" ::: "memory")
#define PG8_WAIT_L(n) asm volatile("s_waitcnt lgkmcnt(" #n ")" ::: "memory")
#define PG8_BAR __builtin_amdgcn_s_barrier()
#define PG8_SCHED __builtin_amdgcn_sched_barrier(0)
    Unit cur, nxt; int ui = 0;
    if (!S.next(0, cur)) return;
    f32x4 acc[2][2][4][2];
#pragma unroll
    for (int a = 0; a < 2; ++a)
#pragma unroll
        for (int b = 0; b < 2; ++b)
#pragma unroll
            for (int m = 0; m < 4; ++m)
#pragma unroll
                for (int n = 0; n < 2; ++n) acc[a][b][m][n] = (f32x4){0.f, 0.f, 0.f, 0.f};
    bf16x8 At[4][2], B0[2][2], B1[2][2];
    const char* cA = (const char*)g.A + (size_t)cur.pm * tstepA; const char* cB = (const char*)g.Bt + (size_t)cur.pn * tstepB;
    S.a_ready(cur);
    if constexpr (SP2) {
        PG8_STAGE(PG8_SB(0, 0), cB, voffB); PG8_STAGE(PG8_SB(0, 1), cB + hstepB, voffB); PG8_STAGE(PG8_SA(0, 0), cA, voffA); PG8_STAGE(PG8_SA(0, 1), cA + hstepA, voffA);
        if (wr == 1) PG8_BAR;
        PG8_WAIT_V(2); PG8_BAR;
        PG8_STAGE(PG8_SB(1, 0), cB + kstep, voffB); PG8_STAGE(PG8_SA(1, 0), cA + kstep, voffA); PG8_STAGE(PG8_SB(1, 1), cB + hstepB + kstep, voffB);
        PG8_WAIT_V(6); PG8_BAR;
    } else {
        PG8_STAGE(PG8_SB(0, 0), cB, voffB); PG8_STAGE(PG8_SA(0, 0), cA, voffA); PG8_STAGE(PG8_SB(0, 1), cB + hstepB, voffB); PG8_STAGE(PG8_SA(0, 1), cA + hstepA, voffA);
        if (wr == 1) PG8_BAR;
        PG8_WAIT_V(4); PG8_BAR;
        PG8_STAGE(PG8_SB(1, 0), cB + kstep, voffB); PG8_STAGE(PG8_SA(1, 0), cA + kstep, voffA); PG8_STAGE(PG8_SB(1, 1), cB + hstepB + kstep, voffB);
        PG8_WAIT_V(6); PG8_BAR;
    }
    for (;;) {
        const bool has_next = S.next(ui + 1, nxt);
        const char* nA = has_next ? (const char*)g.A + (size_t)nxt.pm * tstepA : cA; const char* nB = has_next ? (const char*)g.Bt + (size_t)nxt.pn * tstepB : cB;
#define PG8_MM_BOTH(ai) do { PG8_MMA(ai, 0, At, B0); PG8_MMA(ai, 1, At, B1); } while (0)
#define PG8_MM_H0(ai) PG8_MMA(ai, 0, At, B0)
#define PG8_MM_H1(ai) PG8_MMA(ai, 1, At, B1)
#define PG8_SPBLOCK(MM) do { \
            PG8_LDB(B0, 0, 0); PG8_LDB(B1, 0, 1); PG8_SCHED; PG8_LDA(At, 0, 0); PG8_STAGE(PG8_SA(1, 1), a1 + hstepA, voffA); \
            PG8_WAIT_V(8); PG8_WAIT_L(0); PG8_BAR; MM(0); PG8_BAR; PG8_SCHED; \
            PG8_LDA(At, 0, 1); PG8_STAGE(PG8_SB(0, 0), b2, voffB); PG8_STAGE(PG8_SB(0, 1), b2 + hstepB, voffB); PG8_STAGE(PG8_SA(0, 0), a2, voffA); \
            PG8_WAIT_V(8); PG8_WAIT_L(0); PG8_BAR; MM(1); PG8_BAR; PG8_SCHED; \
            PG8_LDB(B0, 1, 0); PG8_LDB(B1, 1, 1); PG8_SCHED; PG8_LDA(At, 1, 0); PG8_STAGE(PG8_SA(0, 1), a2 + hstepA, voffA); \
            PG8_WAIT_V(8); PG8_WAIT_L(0); PG8_BAR; MM(0); PG8_BAR; PG8_SCHED; \
            PG8_LDA(At, 1, 1); PG8_STAGE(PG8_SB(1, 0), b3, voffB); PG8_STAGE(PG8_SB(1, 1), b3 + hstepB, voffB); PG8_STAGE(PG8_SA(1, 0), a3, voffA); \
            PG8_WAIT_V(8); PG8_WAIT_L(0); PG8_BAR; MM(1); PG8_BAR; PG8_SCHED; \
            } while (0)
#define PG8_TBODY(MM) do { \
            const bool last = (t == nt - 2); \
            const char* a1 = cA + (size_t)(t + 1) * kstep; \
            const char* a2 = last ? nA : cA + (size_t)(t + 2) * kstep; const char* b2 = last ? nB : cB + (size_t)(t + 2) * kstep; \
            const char* a3 = a2 + kstep; const char* b3 = b2 + kstep; \
            if (last && has_next) S.a_ready(nxt); \
            PG8_SPBLOCK(MM); } while (0)
        static_assert(SP2, "this copy keeps only the two-super-phase K-loop");
        if constexpr (Epi::HALFSKIP) { int t = 0; for (; t < (nt >> 1); t += 2) PG8_TBODY(PG8_MM_H0); for (; t < nt; t += 2) PG8_TBODY(PG8_MM_H1); }
        else { for (int t = 0; t < nt; t += 2) PG8_TBODY(PG8_MM_BOTH); }
        if constexpr (ALIGN_EPI) { if (wr == 0) PG8_BAR; }
        if constexpr (!Epi::AFTER_DRAIN) { E(acc, cur, wr, wc, fr, fq); S.done(cur); }
        if (!has_next) break;
#pragma unroll
        for (int a = 0; a < 2; ++a)
#pragma unroll
            for (int b = 0; b < 2; ++b)
#pragma unroll
                for (int m = 0; m < 4; ++m)
#pragma unroll
                    for (int n = 0; n < 2; ++n) acc[a][b][m][n] = (f32x4){0.f, 0.f, 0.f, 0.f};
        cur = nxt; cA = nA; cB = nB; ++ui;
        if constexpr (ALIGN_EPI) { if (wr == 1) PG8_BAR; }
    }
    PG8_WAIT_V(0);
    if constexpr (!ALIGN_EPI) { if (wr == 0) PG8_BAR; }
    PG8_BAR;
    if constexpr (Epi::AFTER_DRAIN) { E.fused(acc, cur, wr, wc, fr, fq, lds, wid, lane); S.done(cur); }
#undef PG8_SA
#undef PG8_SB
#undef PG8_STAGE
#undef PG8_LDA
#undef PG8_LDB
#undef PG8_MMA
#undef PG8_SPBLOCK
#undef PG8_TBODY
#undef PG8_MM_BOTH
#undef PG8_MM_H0
#undef PG8_MM_H1
#undef PG8_WAIT_V
#undef PG8_WAIT_L
#undef PG8_BAR
#undef PG8_SCHED
}
}


#define XB_TMO      128
#define XB_XCNT(j)  (256  + 64 * (j))
#define XB_XSUB(j)  (1280 + 64 * (j))
#define XB_XGEN(j)  (2304 + 64 * (j))
#define XB_TOP      3328
#define XB_TOPGEN   3392
#define XCD_BAR_WORDS 3456
#define XB_SPIN_CAP (1u << 18)

__device__ __forceinline__ unsigned xb_ld(unsigned* p)              { return __hip_atomic_load(p, __ATOMIC_RELAXED, __HIP_MEMORY_SCOPE_AGENT); }
__device__ __forceinline__ unsigned xb_add(unsigned* p, unsigned v) { return __hip_atomic_fetch_add(p, v, __ATOMIC_RELAXED, __HIP_MEMORY_SCOPE_AGENT); }
__device__ __forceinline__ unsigned xb_xcc_id() { return (unsigned)__builtin_amdgcn_s_getreg((3 << 11) | 20) & 0xFu; }
#define XB_SPIN(cond, bar) do { unsigned _sp = 0; while (cond) { __builtin_amdgcn_s_sleep(1); \
    if ((++_sp & 255u) == 0u) { if (xb_ld(&(bar)[XB_TMO])) break; if (_sp > XB_SPIN_CAP) { atomicAdd(&(bar)[XB_TMO], 1u); break; } } } } while (0)

struct XcdBarrier {
    unsigned* bar; unsigned x;
    volatile LAS unsigned* st;
};

__device__ __forceinline__ XcdBarrier xcd_barrier_post(unsigned* bar, volatile LAS unsigned* st) {
    XcdBarrier b; b.bar = bar; b.x = xb_xcc_id(); b.st = st;
    if (threadIdx.x == 0) (void)xb_add(&bar[XB_XCNT(b.x)], 1u);
    return b;
}
__device__ __forceinline__ void xcd_barrier_complete(unsigned* bar, unsigned x, unsigned& nloc, unsigned& nx) {
    const unsigned G = gridDim.x * gridDim.y * gridDim.z;
    unsigned sum, cnt, mine, sp = 0u;
    for (;;) {
        sum = 0u; cnt = 0u; mine = 0u;
#pragma unroll
        for (unsigned j = 0; j < 16; ++j) { const unsigned c = xb_ld(&bar[XB_XCNT(j)]); sum += c; cnt += (c > 0u) ? 1u : 0u; mine = (j == x) ? c : mine; }
        if (sum == G) break;
        __builtin_amdgcn_s_sleep(1);
        if ((++sp & 255u) == 0u) { if (xb_ld(&bar[XB_TMO])) break; if (sp > XB_SPIN_CAP) { atomicAdd(&bar[XB_TMO], 1u); break; } }
    }
    nloc = mine > 0u ? mine : 1u; nx = cnt > 0u ? cnt : 1u;
}

__device__ __forceinline__ void xcd_barrier(const XcdBarrier& b) {
    asm volatile("s_waitcnt vmcnt(0)" ::: "memory");
    __syncthreads();
    if (threadIdx.x == 0) {
        unsigned* bar = b.bar;
        __builtin_amdgcn_s_waitcnt(0);
        unsigned nloc = b.st[0], nx = b.st[1];
        if (nloc == 0u) { xcd_barrier_complete(bar, b.x, nloc, nx); b.st[0] = nloc; b.st[1] = nx; }
        const unsigned old = xb_add(&bar[XB_XSUB(b.x)], 1u);
        const unsigned gen = old / nloc;
        if (old + 1u == (gen + 1u) * nloc) {
            __builtin_amdgcn_fence(__ATOMIC_RELEASE, "agent");
            asm volatile("s_waitcnt vmcnt(0)" ::: "memory");
            const unsigned og = xb_add(&bar[XB_TOP], 1u);
            const unsigned tg = og / nx;
            if (og + 1u == (tg + 1u) * nx) xb_add(&bar[XB_TOPGEN], 1u);
            else XB_SPIN(xb_ld(&bar[XB_TOPGEN]) == tg, bar);
            __builtin_amdgcn_fence(__ATOMIC_ACQUIRE, "agent");
            xb_add(&bar[XB_XGEN(b.x)], 1u);
            asm volatile("s_waitcnt vmcnt(0)" ::: "memory");
        } else {
            XB_SPIN(xb_ld(&bar[XB_XGEN(b.x)]) == gen, bar);
            __builtin_amdgcn_fence(__ATOMIC_ACQUIRE, "agent");
            asm volatile("s_waitcnt vmcnt(0)" ::: "memory");
        }
    }
    __syncthreads();
}

struct Ctx { int tid, lane, wave, blk, nblk; LAS unsigned char* lds; };
#define LDS_WAIT() asm volatile("s_waitcnt lgkmcnt(0)" ::: "memory")

__device__ __forceinline__ float wave_sum(float v) {
#pragma unroll
    for (int o = 1; o < 64; o <<= 1) v += __shfl_xor(v, o);
    return v;
}

__device__ __forceinline__ void prologue(const Params& P, const Ctx& C) {
    const int gw = C.blk * NWAVE + C.wave, NGW = C.nblk * NWAVE;
    {
        LAS float* scr = (LAS float*)(C.lds + C.wave * 16384);
        const int matN[8] = {4096, 768, 1024, 2048, 0, 1024, 5632, 1024};
        const int matK[8] = {1024, 256, 256, 1024, 64, 1024, 1024, 2816};
        const size_t matO[8] = {WO_IN, WO_Q, WO_KV, WO_A, WO_H, WO_O, WO_GU, WO_D};
        constexpr int ITEMS_L = 2048 + 96 + 128 + 1024 + 0 + 512 + 2816 + 1408;
        for (int it = gw; it < 2 * ITEMS_L; it += NGW) {
            const int l = it / ITEMS_L; int r = it % ITEMS_L; int mat = 0;
#pragma unroll
            for (int q = 0; q < 8; ++q) { const int ni = (matK[q] / 64) * (matN[q] / 32); if (mat == q && r >= ni) { r -= ni; mat = q + 1; } }
            int N = 0, K = 0; size_t off = 0;
#pragma unroll
            for (int q = 0; q < 8; ++q) if (mat == q) { N = matN[q]; K = matK[q]; off = matO[q]; }
            bf16_t* WT = mat == 3 ? (bf16_t*)(P.ws + WS_WM + (size_t)l * WM_LAYER) : (bf16_t*)(P.ws + WS_W + (size_t)l * W_LAYER + off);
            const int nblk = N / 32, kb = r / nblk, nb = r % nblk, k0 = 64 * kb, n0 = 32 * nb, n = n0 + (C.lane & 31);
            const float* colp = P.in[3]; int ldw = 0, kmax = K, kmin = 0; const float* gp = nullptr; bool valid = true;
            switch (mat) {
            case 0: { const int sc = n < 416 ? n : (n < 512 ? -1 : n - 96); valid = sc >= 0; colp = P.in[3] + (size_t)l * DM * INC + (valid ? sc : 0); ldw = INC; gp = P.in[2] + l * DM; } break;
            case 1: colp = P.in[5] + (size_t)l * QL * 768 + n; ldw = 768; gp = P.in[4] + l * QL; break;
            case 2: colp = P.in[7] + (size_t)l * KVL * 1024 + n; ldw = 1024; gp = P.in[6] + l * KVL; kmax = KVL; break;
            case 3: { const int bj = (n >> 7) & 1, col = (n >> 8) * 128 + (n & 127); ldw = DM;
                      if (bj == 0) { colp = P.in[8] + (size_t)l * 512 * DM + col; kmax = 512; } else { colp = P.in[22] + (size_t)l * DHY * DM + col; kmin = 512; } } break;
            case 4: break;
            case 5: colp = P.in[23] + (size_t)l * DM * DM + n; ldw = DM; break;
            case 6: { const int sel = (n >> 2) & 1, col = (n >> 3) * 4 + (n & 3); colp = P.in[sel ? 26 : 25] + (size_t)l * DM * DFF + col; ldw = DFF; gp = P.in[24] + l * DM; } break;
            default: colp = P.in[27] + (size_t)l * DFF * DM + n; ldw = DM; break;
            }
            float v[32];
#pragma unroll
            for (int i = 0; i < 32; ++i) { const int k = k0 + 2 * i + (C.lane >> 5); const int kc = (k < kmax && k >= kmin) ? k - kmin : 0; v[i] = colp[(size_t)kc * ldw]; }
            if (gp) {
#pragma unroll
                for (int i = 0; i < 32; ++i) { const int k = k0 + 2 * i + (C.lane >> 5); const int kc = k < kmax ? k : 0; v[i] *= gp[kc]; } }
            if (mat == 1) {
#pragma unroll
                for (int i = 0; i < 32; ++i) v[i] *= att::QSCALE; }
#pragma unroll
            for (int i = 0; i < 32; ++i) { const int kk = 2 * i + (C.lane >> 5); scr[kk * 33 + (C.lane & 31)] = (valid && (k0 + kk) < kmax && (k0 + kk) >= kmin) ? v[i] : 0.f; }
            LDS_WAIT();
            const int c = C.lane & 7;
#pragma unroll
            for (int j = 0; j < 4; ++j) { const int nn = (C.lane >> 3) + 8 * j; const LAS float* sp = scr + (8 * c) * 33 + nn;
                u32x4 o; o.x = pk2(sp[0 * 33], sp[1 * 33]); o.y = pk2(sp[2 * 33], sp[3 * 33]); o.z = pk2(sp[4 * 33], sp[5 * 33]); o.w = pk2(sp[6 * 33], sp[7 * 33]);
                *(u32x4*)(WT + (size_t)(n0 + nn) * K + k0 + 8 * c) = o; }
            LDS_WAIT();
        }
    }
    {
        f32x2* cs = (f32x2*)(P.ws + WS_ROPE); const int* pos = (const int*)P.in[1];
        for (int idx = C.blk * NTHR + C.tid; idx < SEQ * 16; idx += C.nblk * NTHR) {
            const int s = idx >> 4, i = idx & 15; const float inv = 1.0f / powf(10000.0f, (float)(2 * i) / 32.0f); const float a = (float)pos[s] * inv;
            cs[idx] = (f32x2){cosf(a), sinf(a)}; }
    }
    {
        bf16_t* taps = (bf16_t*)(P.ws + WS_TAPS);
        for (int task = gw; task < 2 * (SEQ / 4); task += NGW) {
            const int l = task >> 9, p0 = (task & 511) * 4, lane = C.lane;
            const float* w1 = P.in[11] + l * 33 * 64; const float* w2 = P.in[14] + l * 4096; const float* w3 = P.in[17] + l * 4096; const float* w4 = P.in[20] + (size_t)l * 64 * 1024;
            float zv[4], tq[4], h[4], a[4];
#pragma unroll
            for (int q = 0; q < 4; ++q) { const int p = p0 + q; tq[q] = (float)p / 2047.0f; const float w = 6.283185307179586f * (float)p / 2048.0f;
                float z = 0.f;
                if (lane == 0) z = tq[q];
                else if (lane <= 16) { const float fr = 1e-4f + (float)(lane - 1) * ((15.0f - 1e-4f) / 15.0f); z = cosf(fr * w); }
                else if (lane <= 32) { const float fr = 1e-4f + (float)(lane - 17) * ((15.0f - 1e-4f) / 15.0f); z = -sinf(fr * w); }
                zv[q] = z; a[q] = 0.f; }
#pragma unroll 1
            for (int e0 = 0; e0 < 33; e0 += 11) { float wv[11];
#pragma unroll
                for (int j = 0; j < 11; ++j) wv[j] = w1[(e0 + j) * 64 + lane];
#pragma unroll
                for (int j = 0; j < 11; ++j) {
#pragma unroll
                    for (int q = 0; q < 4; ++q) a[q] += __shfl(zv[q], e0 + j) * wv[j]; } }
            { const float ff = P.in[13][l * 64 + lane], bb = P.in[12][l * 64 + lane];
#pragma unroll
              for (int q = 0; q < 4; ++q) { h[q] = sinf(ff * (a[q] + bb)); a[q] = 0.f; } }
            asm volatile("" ::: "memory");
#pragma unroll 1
            for (int k0 = 0; k0 < 64; k0 += 16) { float wv[16];
#pragma unroll
                for (int j = 0; j < 16; ++j) wv[j] = w2[(k0 + j) * 64 + lane];
#pragma unroll
                for (int j = 0; j < 16; ++j) {
#pragma unroll
                    for (int q = 0; q < 4; ++q) a[q] += __shfl(h[q], k0 + j) * wv[j]; } }
            { const float ff = P.in[16][l * 64 + lane], bb = P.in[15][l * 64 + lane];
#pragma unroll
              for (int q = 0; q < 4; ++q) { h[q] = sinf(ff * (a[q] + bb)); a[q] = 0.f; } }
            asm volatile("" ::: "memory");
#pragma unroll 1
            for (int k0 = 0; k0 < 64; k0 += 16) { float wv[16];
#pragma unroll
                for (int j = 0; j < 16; ++j) wv[j] = w3[(k0 + j) * 64 + lane];
#pragma unroll
                for (int j = 0; j < 16; ++j) {
#pragma unroll
                    for (int q = 0; q < 4; ++q) a[q] += __shfl(h[q], k0 + j) * wv[j]; } }
            { const float ff = P.in[19][l * 64 + lane], bb = P.in[18][l * 64 + lane];
#pragma unroll
              for (int q = 0; q < 4; ++q) h[q] = sinf(ff * (a[q] + bb)); }
            asm volatile("" ::: "memory");
            float o[4][16];
#pragma unroll
            for (int q = 0; q < 4; ++q)
#pragma unroll
                for (int m = 0; m < 16; ++m) o[q][m] = 0.f;
#pragma unroll 2
            for (int k = 0; k < 64; ++k) {
                float ww[16];
#pragma unroll
                for (int m = 0; m < 16; ++m) ww[m] = w4[k * 1024 + lane + 64 * m];
#pragma unroll
                for (int q = 0; q < 4; ++q) { const float hk = __shfl(h[q], k);
#pragma unroll
                    for (int m = 0; m < 16; ++m) o[q][m] += hk * ww[m]; } }
            const float dlo = -15.350567286626974f, dhi = -3.0701134573253946f;
#pragma unroll
            for (int m = 0; m < 16; ++m) {
                const int n = lane + 64 * m, c = n & 511;
                const float delta = fabsf(dlo + (float)c * ((dhi - dlo) / 511.0f));
                const float skip = P.in[21][l * DHY + c];
#pragma unroll
                for (int q = 0; q < 4; ++q) {
                    const int p = p0 + q;
                    float val = o[q][m] * expf(-tq[q] * delta);
                    int idx;
                    if (n < 512) { idx = 2047 - p; if (p == 0) val += skip; }
                    else { idx = 2047 + p; if (p == 0) { idx = 4095; val = 0.f; } }
                    taps[((size_t)(l * DHY + c)) * 4096 + idx] = (bf16_t)f2bf(val);
                }
            }
        }
    }
}

__device__ __forceinline__ void xcast_rows(const Ctx& C, const float* x, bf16_t* out, float* ssq) {
    const int gw = C.blk * NWAVE + C.wave, NGW = C.nblk * NWAVE;
    for (int m = gw; m < MTOK; m += NGW) {
        const f32x4* xr = (const f32x4*)(x + (size_t)m * DM) + C.lane;
        f32x4 v[4]; float s = 0.f;
#pragma unroll
        for (int j = 0; j < 4; ++j) { v[j] = xr[64 * j]; s += (v[j].x * v[j].x + v[j].y * v[j].y) + (v[j].z * v[j].z + v[j].w * v[j].w); }
        s = wave_sum(s);
        if (C.lane < 4) ssq[(size_t)m * 4 + C.lane] = C.lane == 0 ? s : 0.f;
        u32x2* o8 = (u32x2*)(out + (size_t)m * DM) + C.lane;
#pragma unroll
        for (int j = 0; j < 4; ++j) { u32x2 w; w.x = cvt_pk_bf16(v[j].x, v[j].y); w.y = cvt_pk_bf16(v[j].z, v[j].w); o8[64 * j] = w; }
    }
}
__device__ __forceinline__ void rmsnorm_final(const Ctx& C, const bf16_t* x, float* y, const float* g) {
    const int gw = C.blk * NWAVE + C.wave, NGW = C.nblk * NWAVE;
    f32x4 gv[4];
#pragma unroll
    for (int j = 0; j < 4; ++j) gv[j] = ((const f32x4*)g)[64 * j + C.lane];
    for (int m = gw; m < MTOK; m += NGW) {
        const u32x2* xr = (const u32x2*)(x + (size_t)m * DM) + C.lane; f32x4* yr = (f32x4*)(y + (size_t)m * DM) + C.lane;
        f32x4 v[4]; float s = 0.f;
#pragma unroll
        for (int j = 0; j < 4; ++j) { const u32x2 w = xr[64 * j];
            v[j] = (f32x4){__uint_as_float(w.x << 16), __uint_as_float(w.x & 0xffff0000u), __uint_as_float(w.y << 16), __uint_as_float(w.y & 0xffff0000u)};
            s += (v[j].x * v[j].x + v[j].y * v[j].y) + (v[j].z * v[j].z + v[j].w * v[j].w); }
        const float rstd = rsqrtf(wave_sum(s) * (1.0f / DM) + EPS);
#pragma unroll
        for (int j = 0; j < 4; ++j) yr[64 * j] = v[j] * rstd * gv[j];
    }
}

struct FInProj {
    bf16_t* lat; bf16_t* hyin; unsigned char* gates; const float* ssq;
    __device__ __forceinline__ float rowscale(int row) const { const f32x4 a = *(const f32x4*)(ssq + (size_t)row * 4); return rsqrtf(((a.x + a.y) + (a.z + a.w)) * (1.0f / DM) + EPS); }
    __device__ __forceinline__ void operator()(int row, int col0, f32x4 v0, f32x4 v1) const {
        if (col0 >= 2048) {
            unsigned q0[4], q1[4];
#pragma unroll
            for (int e = 0; e < 4; ++e) { q0[e] = (unsigned)(fast_sigmoid(v0[e]) * 255.0f + 0.5f); q1[e] = (unsigned)(fast_sigmoid(v1[e]) * 255.0f + 0.5f); }
            u32x2 w; w.x = q0[0] | (q0[1] << 8) | (q0[2] << 16) | (q0[3] << 24); w.y = q1[0] | (q1[1] << 8) | (q1[2] << 16) | (q1[3] << 24);
            *(u32x2*)(gates + (size_t)row * 2048 + (col0 - 2048)) = w;
            return; }
        bf16_t* dst = col0 < 512 ? lat + (size_t)row * 512 + col0 : hyin + (size_t)row * 1536 + (col0 - 512);
        u32x4 w; w.x = cvt_pk_bf16(v0[0], v0[1]); w.y = cvt_pk_bf16(v0[2], v0[3]); w.z = cvt_pk_bf16(v1[0], v1[1]); w.w = cvt_pk_bf16(v1[2], v1[3]);
        *(u32x4*)dst = w;
    }
};
struct FPlain {
    bf16_t* dst; int ldc;
    __device__ __forceinline__ float rowscale(int) const { return 1.0f; }
    __device__ __forceinline__ void operator()(int row, int col0, f32x4 v0, f32x4 v1) const {
        u32x4 w; w.x = cvt_pk_bf16(v0[0], v0[1]); w.y = cvt_pk_bf16(v0[2], v0[3]); w.z = cvt_pk_bf16(v1[0], v1[1]); w.w = cvt_pk_bf16(v1[2], v1[3]);
        *(u32x4*)(dst + (size_t)row * ldc + col0) = w;
    }
};
struct EpiMerge2 {
    static constexpr bool PERM = true, AFTER_DRAIN = false, HALFSKIP = true;
    const unsigned char* gates; bf16_t* merged;
    __device__ __forceinline__ void operator()(const f32x4 (&acc)[2][2][4][2], const pg8::Unit& u, int wr, int wc, int fr, int fq) const {
#pragma unroll
        for (int ai = 0; ai < 2; ++ai) {
            u32x2 ga[4], gb[4];
#pragma unroll
            for (int m = 0; m < 4; ++m) { const size_t g = (size_t)(u.pm * 256 + ai * 128 + wr * 64 + m * 16 + fr) * 2048 + u.pn * 128 + wc * 32 + 8 * fq;
                ga[m] = *(const u32x2*)(gates + g); gb[m] = *(const u32x2*)(gates + g + 1024); }
#pragma unroll
            for (int m = 0; m < 4; ++m) { const int row = u.pm * 256 + ai * 128 + wr * 64 + m * 16 + fr;
                float o[8];
#pragma unroll
                for (int e = 0; e < 4; ++e) {
                    const float a0 = (float)((ga[m].x >> (8 * e)) & 255u) * (1.0f / 255.0f), a1 = (float)((ga[m].y >> (8 * e)) & 255u) * (1.0f / 255.0f);
                    const float b0 = (float)((gb[m].x >> (8 * e)) & 255u) * (1.0f / 255.0f), b1 = (float)((gb[m].y >> (8 * e)) & 255u) * (1.0f / 255.0f);
                    o[e] = a0 * acc[ai][0][m][0][e] + b0 * acc[ai][1][m][0][e]; o[4 + e] = a1 * acc[ai][0][m][1][e] + b1 * acc[ai][1][m][1][e]; }
                *(u32x4*)(merged + (size_t)row * DM + u.pn * 128 + wc * 32 + 8 * fq) = pack8(o); }
            asm volatile("" ::: "memory"); }
    }
};
struct FSwiglu {
    bf16_t* act; const float* ssq;
    __device__ __forceinline__ float rowscale(int row) const { const f32x4 a = *(const f32x4*)(ssq + (size_t)row * 4); return rsqrtf(((a.x + a.y) + (a.z + a.w)) * (1.0f / DM) + EPS); }
    __device__ __forceinline__ void operator()(int row, int col0, f32x4 v0, f32x4 v1) const {
        float o[4];
#pragma unroll
        for (int e = 0; e < 4; ++e) o[e] = v0[e] * fast_sigmoid(v0[e]) * v1[e];
        u32x2 w; w.x = cvt_pk_bf16(o[0], o[1]); w.y = cvt_pk_bf16(o[2], o[3]);
        *(u32x2*)(act + (size_t)row * DFF + (col0 >> 1)) = w;
    }
};
struct EpiResid {
    static constexpr bool PERM = false, AFTER_DRAIN = false, HALFSKIP = false;
    const float* base; float* out; bf16_t* xb; float* ssq;
    __device__ __forceinline__ void operator()(const f32x4 (&acc)[2][2][4][2], const pg8::Unit& u, int wr, int wc, int fr, int fq) const {
#pragma unroll
        for (int ai = 0; ai < 2; ++ai) {
            f32x4 r[4][2][2];
#pragma unroll
            for (int m = 0; m < 4; ++m)
#pragma unroll
                for (int bj = 0; bj < 2; ++bj)
#pragma unroll
                    for (int n = 0; n < 2; ++n) r[m][bj][n] = *(const f32x4*)(base + (size_t)(u.pm * 256 + ai * 128 + wr * 64 + m * 16 + fr) * DM + u.pn * 256 + bj * 128 + wc * 32 + 16 * n + 4 * fq);
#pragma unroll
            for (int m = 0; m < 4; ++m) { const int row = u.pm * 256 + ai * 128 + wr * 64 + m * 16 + fr; float s = 0.f;
#pragma unroll
                for (int bj = 0; bj < 2; ++bj)
#pragma unroll
                    for (int n = 0; n < 2; ++n) { const size_t off = (size_t)row * DM + u.pn * 256 + bj * 128 + wc * 32 + 16 * n + 4 * fq;
                        const f32x4 o = r[m][bj][n] + acc[ai][bj][m][n]; *(f32x4*)(out + off) = o;
                        if (xb) { u32x2 w; w.x = cvt_pk_bf16(o[0], o[1]); w.y = cvt_pk_bf16(o[2], o[3]); *(u32x2*)(xb + off) = w; }
                        s += (o[0] * o[0] + o[1] * o[1]) + (o[2] * o[2] + o[3] * o[3]); }
                s += __shfl_xor(s, 16); s += __shfl_xor(s, 32);
                if (xb && fq == 0) unsafeAtomicAdd(ssq + row, s); }
            asm volatile("" ::: "memory"); }
    }
};
struct EpiResidB {
    static constexpr bool PERM = true, AFTER_DRAIN = false, HALFSKIP = false;
    bf16_t* xb; float* ssq; LAS float* tab;
    __device__ __forceinline__ void operator()(const f32x4 (&acc)[2][2][4][2], const pg8::Unit& u, int wr, int wc, int fr, int fq) const {
#pragma unroll
        for (int ai = 0; ai < 2; ++ai) {
            u32x4 r[4][2];
#pragma unroll
            for (int m = 0; m < 4; ++m)
#pragma unroll
                for (int bj = 0; bj < 2; ++bj) r[m][bj] = *(const u32x4*)(xb + (size_t)(u.pm * 256 + ai * 128 + wr * 64 + m * 16 + fr) * DM + u.pn * 256 + bj * 128 + wc * 32 + 8 * fq);
#pragma unroll
            for (int m = 0; m < 4; ++m) { const int rl = ai * 128 + wr * 64 + m * 16 + fr, row = u.pm * 256 + rl; float s = 0.f;
#pragma unroll
                for (int bj = 0; bj < 2; ++bj) { float f[8], o[8]; unpack8(r[m][bj], f);
#pragma unroll
                    for (int e = 0; e < 4; ++e) { o[e] = f[e] + acc[ai][bj][m][0][e]; o[4 + e] = f[4 + e] + acc[ai][bj][m][1][e]; }
#pragma unroll
                    for (int e = 0; e < 8; ++e) s += o[e] * o[e];
                    *(u32x4*)(xb + (size_t)row * DM + u.pn * 256 + bj * 128 + wc * 32 + 8 * fq) = pack8(o); }
                s += __shfl_xor(s, 16); s += __shfl_xor(s, 32);
                if (fq == 0) tab[rl * 4 + wc] = s; }
            asm volatile("" ::: "memory"); }
        asm volatile("s_waitcnt lgkmcnt(0)\n\ts_barrier" ::: "memory");
        const int t = wr * 256 + wc * 64 + fq * 16 + fr;
        if (t < 256) { const f32x4 p = *(const LAS f32x4*)(tab + t * 4); ssq[(size_t)(u.pm * 256 + t) * 4 + u.pn] = (p.x + p.y) + (p.z + p.w); }
    }
};
struct EpiResidF {
    static constexpr bool PERM = true, AFTER_DRAIN = false, HALFSKIP = false;
    const bf16_t* xb; bf16_t* xf;
    __device__ __forceinline__ void operator()(const f32x4 (&acc)[2][2][4][2], const pg8::Unit& u, int wr, int wc, int fr, int fq) const {
#pragma unroll
        for (int ai = 0; ai < 2; ++ai) {
            u32x4 r[4][2];
#pragma unroll
            for (int m = 0; m < 4; ++m)
#pragma unroll
                for (int bj = 0; bj < 2; ++bj) r[m][bj] = *(const u32x4*)(xb + (size_t)(u.pm * 256 + ai * 128 + wr * 64 + m * 16 + fr) * DM + u.pn * 256 + bj * 128 + wc * 32 + 8 * fq);
#pragma unroll
            for (int m = 0; m < 4; ++m) { const int row = u.pm * 256 + ai * 128 + wr * 64 + m * 16 + fr;
#pragma unroll
                for (int bj = 0; bj < 2; ++bj) { float f[8], o[8]; unpack8(r[m][bj], f);
#pragma unroll
                    for (int e = 0; e < 4; ++e) { o[e] = f[e] + acc[ai][bj][m][0][e]; o[4 + e] = f[4 + e] + acc[ai][bj][m][1][e]; }
                    *(u32x4*)(xf + (size_t)row * DM + u.pn * 256 + bj * 128 + wc * 32 + 8 * fq) = pack8(o); } }
            asm volatile("" ::: "memory"); }
    }
};
template <class E>
__device__ __forceinline__ void run_gemm_epi(const Ctx& C, const bf16_t* A, int lda, const bf16_t* Bt, int N, int K, const E& e) {
    pg8::Gemm g{A, Bt, MTOK, N, K, lda}; pg8::StaticOrder S; S.init(MTOK, N, C.nblk, C.blk);
#if FAST_GEMM
    pg8::gemm_phase<E, pg8::StaticOrder, true, true>(C.lds, g, S, e);
#else
    pg8::gemm_simple<E, pg8::StaticOrder>(g, S, e);
#endif
}

template <class F, bool P8> struct EpiSel { typedef pg8::Epi8<F> type; };
template <class F> struct EpiSel<F, false> { typedef pg8::Epi4<F> type; };
template <bool P8, bool SIMPLE = false, class F>
__device__ __forceinline__ void run_gemm(const Ctx& C, const bf16_t* A, int lda, const bf16_t* Bt, int N, int K, const F& f) {
    typedef typename EpiSel<F, P8>::type E; E e{f};
    pg8::Gemm g{A, Bt, MTOK, N, K, lda}; pg8::StaticOrder S; S.init(MTOK, N, C.nblk, C.blk);
#if FAST_GEMM
    if constexpr (SIMPLE) pg8::gemm_simple<E, pg8::StaticOrder>(g, S, e);
    else pg8::gemm_phase<E, pg8::StaticOrder, true, true>(C.lds, g, S, e);
#else
    pg8::gemm_simple<E, pg8::StaticOrder>(g, S, e);
#endif
}

__device__ __forceinline__ void lat_rows(const Ctx& C, bf16_t* lat, const f32x2* cs, bf16_t* kpe) {
    const int gw = C.blk * NWAVE + C.wave, NGW = C.nblk * NWAVE, lane = C.lane;
    for (int m0 = gw * 4; m0 < MTOK; m0 += NGW * 4) {
        u32x4 raw[4];
#pragma unroll
        for (int r = 0; r < 4; ++r) raw[r] = *(const u32x4*)(lat + (size_t)(m0 + r) * 512 + 8 * lane);
#pragma unroll
        for (int r = 0; r < 4; ++r) {
            const int m = m0 + r; bf16_t* lp = lat + (size_t)m * 512 + 8 * lane;
            float f[8]; unpack8(raw[r], f);
            float s = 0.f;
#pragma unroll
            for (int e = 0; e < 8; ++e) s += f[e] * f[e];
            s += __shfl_xor(s, 1); s += __shfl_xor(s, 2); s += __shfl_xor(s, 4); s += __shfl_xor(s, 8);
            const float s32 = s + __shfl_xor(s, 16);
            const float rs = lane < 32 ? rsqrtf(s32 * (1.0f / QL) + EPS) : rsqrtf(s * (1.0f / KVL) + EPS);
            if (lane < 48) {
#pragma unroll
                for (int e = 0; e < 8; ++e) f[e] *= rs;
                *(u32x4*)lp = pack8(f);
            } else if (lane < 52) {
                const int sq = m & 2047, i0 = (lane - 48) * 4; const f32x2* c = cs + sq * 16 + i0;
                float o[8];
#pragma unroll
                for (int p = 0; p < 4; ++p) { const f32x2 cc = c[p]; o[2 * p] = f[2 * p] * cc.x - f[2 * p + 1] * cc.y; o[2 * p + 1] = f[2 * p] * cc.y + f[2 * p + 1] * cc.x; }
                *(u32x4*)(kpe + (size_t)m * ROPE + 8 * (lane - 48)) = pack8(o);
            }
        }
    }
}
constexpr int TR_RS = 1028;
__device__ __forceinline__ void hy_load10(const bf16_t* base, int t0, int cg, u32x4* rows) {
#pragma unroll
    for (int i = 0; i < 10; ++i) { const int t = t0 - 1 + i; const int tc = t < 0 ? 0 : (t > SEQ - 1 ? SEQ - 1 : t);
        u32x4 v = *(const u32x4*)(base + (size_t)tc * 1536 + 8 * cg);
        if (t < 0 || t > SEQ - 1) v = (u32x4){0u, 0u, 0u, 0u};
        rows[i] = v; }
}
__device__ __forceinline__ void hy_conv_row(const u32x4& ra, const u32x4& rb, const u32x4& rc, const float* w0, const float* w1, const float* w2, const float* bias, float* o) {
    float a[8], b[8], c[8]; unpack8(ra, a); unpack8(rb, b); unpack8(rc, c);
#pragma unroll
    for (int e = 0; e < 8; ++e) o[e] = a[e] * w0[e] + b[e] * w1[e] + c[e] * w2[e] + bias[e];
}
__device__ __forceinline__ void hy_pre(const Ctx& C, const bf16_t* hyin, const float* cw, const float* cb, bf16_t* x0c, bf16_t* zT) {
    const int cg = C.tid & 63, tw = C.tid >> 6;
    float w[3][3][8], bs[3][8];
#pragma unroll
    for (int q = 0; q < 3; ++q) {
#pragma unroll
        for (int k = 0; k < 3; ++k)
#pragma unroll
            for (int e = 0; e < 8; ++e) w[q][k][e] = cw[k * 1536 + q * 512 + 8 * cg + e];
#pragma unroll
        for (int e = 0; e < 8; ++e) bs[q][e] = cb[q * 512 + 8 * cg + e];
    }
    for (int it = C.blk; it < NB * (SEQ / 64); it += C.nblk) {
        const int b = it >> 5, t0 = (it & 31) * 64, tb = t0 + tw * 8;
        const bf16_t* hb = hyin + (size_t)b * SEQ * 1536;
        __syncthreads();
        {   u32x4 r0[10]; hy_load10(hb, tb, cg, r0);
#pragma unroll
            for (int tt = 0; tt < 8; ++tt) { float o0[8]; hy_conv_row(r0[tt], r0[tt + 1], r0[tt + 2], w[0][0], w[0][1], w[0][2], bs[0], o0);
                *(u32x4*)(x0c + ((size_t)b * SEQ + tb + tt) * DHY + 8 * cg) = pack8(o0); } }
        asm volatile("" ::: "memory");
#pragma unroll 1
        for (int hh = 0; hh < 2; ++hh) {
            u32x4 r1[6], r2[6];
#pragma unroll
            for (int i = 0; i < 6; ++i) { const int t = tb + 4 * hh - 1 + i; const int tc = t < 0 ? 0 : (t > SEQ - 1 ? SEQ - 1 : t); const bool oob = (t < 0 || t > SEQ - 1);
                u32x4 v1 = *(const u32x4*)(hb + 512 + (size_t)tc * 1536 + 8 * cg), v2 = *(const u32x4*)(hb + 1024 + (size_t)tc * 1536 + 8 * cg);
                if (oob) { v1 = (u32x4){0u, 0u, 0u, 0u}; v2 = (u32x4){0u, 0u, 0u, 0u}; }
                r1[i] = v1; r2[i] = v2; }
#pragma unroll
            for (int tt = 0; tt < 4; ++tt) { float o1[8], o2[8], z[8];
                hy_conv_row(r1[tt], r1[tt + 1], r1[tt + 2], w[1][0], w[1][1], w[1][2], bs[1], o1);
                hy_conv_row(r2[tt], r2[tt + 1], r2[tt + 2], w[2][0], w[2][1], w[2][2], bs[2], o2);
#pragma unroll
                for (int e = 0; e < 8; ++e) z[e] = o2[e] * o1[e];
                const u32x4 zw = pack8(z);
                LAS unsigned* d = (LAS unsigned*)(C.lds + (tw * 8 + 4 * hh + tt) * TR_RS + 16 * cg);
                d[0] = zw.x; d[1] = zw.y; d[2] = zw.z; d[3] = zw.w; } }
        __syncthreads();
        const int ch = C.tid & 7;
        for (int ps = 0; ps < 8; ++ps) {
            const int c = (C.tid >> 3) + 64 * ps;
            unsigned short v[8];
#pragma unroll
            for (int j = 0; j < 8; ++j) v[j] = *(const LAS unsigned short*)(C.lds + (8 * ch + j) * TR_RS + 2 * c);
            u32x4 o; o.x = v[0] | ((unsigned)v[1] << 16); o.y = v[2] | ((unsigned)v[3] << 16); o.z = v[4] | ((unsigned)v[5] << 16); o.w = v[6] | ((unsigned)v[7] << 16);
            *(u32x4*)(zT + ((size_t)c * NB + b) * SEQ + t0 + 8 * ch) = o;
        }
    }
}
__device__ __forceinline__ void hy_post(const Ctx& C, const bf16_t* yT, const bf16_t* x0c, bf16_t* oy) {
    const int cg = C.tid & 63, tw = C.tid >> 6, ch = C.tid & 7;
    for (int it = C.blk; it < NB * (SEQ / 64); it += C.nblk) {
        const int b = it >> 5, t0 = (it & 31) * 64;
        __syncthreads();
        for (int ps = 0; ps < 8; ++ps) {
            const int c = (C.tid >> 3) + 64 * ps;
            const u32x4 o = *(const u32x4*)(yT + ((size_t)c * NB + b) * SEQ + t0 + 8 * ch);
            const unsigned short v[8] = {(unsigned short)(o.x & 0xffff), (unsigned short)(o.x >> 16), (unsigned short)(o.y & 0xffff), (unsigned short)(o.y >> 16),
                                         (unsigned short)(o.z & 0xffff), (unsigned short)(o.z >> 16), (unsigned short)(o.w & 0xffff), (unsigned short)(o.w >> 16)};
#pragma unroll
            for (int j = 0; j < 8; ++j) *(LAS unsigned short*)(C.lds + (8 * ch + j) * TR_RS + 2 * c) = v[j];
        }
        __syncthreads();
        u32x4 xr[8];
#pragma unroll
        for (int tt = 0; tt < 8; ++tt) xr[tt] = *(const u32x4*)(x0c + ((size_t)b * SEQ + t0 + tw * 8 + tt) * DHY + 8 * cg);
#pragma unroll
        for (int tt = 0; tt < 8; ++tt) {
            const int tl = tw * 8 + tt, t = t0 + tl;
            const LAS unsigned* sp = (const LAS unsigned*)(C.lds + tl * TR_RS + 16 * cg);
            u32x4 yw; yw.x = sp[0]; yw.y = sp[1]; yw.z = sp[2]; yw.w = sp[3];
            float y[8], x[8]; unpack8(yw, y); unpack8(xr[tt], x);
#pragma unroll
            for (int e = 0; e < 8; ++e) y[e] *= x[e];
            *(u32x4*)(oy + ((size_t)b * SEQ + t) * 1024 + 512 + 8 * cg) = pack8(y);
        }
    }
}

namespace att {
constexpr int NW = 8, QBLK = 32, KVBLK = 64;
constexpr float SCALE = 0.10206207261596575f;
constexpr float THR = 8.f;
constexpr int SHM_V = KVBLK * VH * 2  , SHM_K = KVBLK * 256  ;
constexpr int NSLOT = 3;
constexpr int LDS_ATT = NSLOT * SHM_V + NSLOT * SHM_K + NW * 64 * 4;
#define KSWZ(row, colB) ((row) * 256 + ((colB) ^ (((row) & 7) << 4)))
#define SBAR() __builtin_amdgcn_sched_barrier(0)
__device__ __forceinline__ int crow(int r, int hi) { return (r & 3) + 8 * (r >> 2) + 4 * hi; }
__device__ __forceinline__ unsigned cvtpk(float lo, float hi) { unsigned r; asm volatile("v_cvt_pk_bf16_f32 %0, %1, %2" : "=v"(r) : "v"(lo), "v"(hi)); return r; }

template <bool FIRST>
__device__ __forceinline__ void partialSM(f32x16& p0, f32x16& p1, float& M, f32x16& negm, float& alpha) {
  constexpr float THR2 = THR * 1.4426950408889634f;
#define MX3(a, b, c) __builtin_fmaxf(__builtin_fmaxf((a), (b)), (c))
  float a = MX3(p0[0], p0[1], p1[0]), b = MX3(p0[2], p0[3], p1[1]); a = MX3(a, p1[2], p1[3]);
#pragma unroll
  for (int r = 4; r < 16; r += 4) { a = MX3(a, p0[r], p0[r + 1]); b = MX3(b, p0[r + 2], p0[r + 3]); a = MX3(a, p1[r], p1[r + 1]); b = MX3(b, p1[r + 2], p1[r + 3]); }
#undef MX3
  float pmax = fmaxf(a, b);
  { auto rr = __builtin_amdgcn_permlane32_swap(__float_as_uint(pmax), __float_as_uint(pmax), false, false);
    pmax = fmaxf(__uint_as_float(rr[0]), __uint_as_float(rr[1])); }
  alpha = 1.f;
  if (FIRST || !__builtin_expect(__all(pmax <= THR2), 1)) {
    const float dl = FIRST ? pmax : fmaxf(pmax, 0.f);
#pragma unroll
    for (int r = 0; r < 16; ++r) { p0[r] -= dl; p1[r] -= dl; }
    M += dl;
#pragma unroll
    for (int r = 0; r < 16; ++r) negm[r] = -M;
    if (!FIRST) alpha = __builtin_amdgcn_exp2f(-dl);
  }
#pragma unroll
  for (int r = 0; r < 16; ++r) p0[r] = __builtin_amdgcn_exp2f(p0[r]);
}
__device__ __forceinline__ void finishSM(f32x16& p0, f32x16& p1, float alpha, float& l_reg, bf16x8& pa0, bf16x8& pa1, bf16x8& pa2, bf16x8& pa3) {
#pragma unroll
  for (int r = 0; r < 16; ++r) p1[r] = __builtin_amdgcn_exp2f(p1[r]);
  f32x2 s2 = (f32x2){p0[0], p0[1]};
#pragma unroll
  for (int r = 2; r < 16; r += 2) s2 += (f32x2){p0[r], p0[r + 1]};
#pragma unroll
  for (int r = 0; r < 16; r += 2) s2 += (f32x2){p1[r], p1[r + 1]};
  float ps = s2.x + s2.y;
  { auto rr = __builtin_amdgcn_permlane32_swap(__float_as_uint(ps), __float_as_uint(ps), false, false);
    ps = __uint_as_float(rr[0]) + __uint_as_float(rr[1]); }
  l_reg = l_reg * alpha + ps;
#define PK4(P, BASE, OUT) do { u32x4 w = {cvtpk(P[BASE + 0], P[BASE + 1]), cvtpk(P[BASE + 2], P[BASE + 3]), cvtpk(P[BASE + 4], P[BASE + 5]), cvtpk(P[BASE + 6], P[BASE + 7])}; \
    OUT = *reinterpret_cast<bf16x8*>(&w); } while (0)
  PK4(p0, 0, pa0); PK4(p0, 8, pa1); PK4(p1, 0, pa2); PK4(p1, 8, pa3);
#undef PK4
}
__device__ __forceinline__ void qkt(f32x16& p0, f32x16& p1, const char* Ks, const bf16x8* qr, const f32x16& negm, int r32, int hi) {
#pragma unroll
  for (int d0 = 0; d0 < 6; ++d0) { int cb = (d0 * 16 + hi * 8) * 2;
    bf16x8 b0 = *reinterpret_cast<const bf16x8*>(Ks + KSWZ(r32, cb));
    bf16x8 b1 = *reinterpret_cast<const bf16x8*>(Ks + KSWZ(32 + r32, cb));
    if (d0 == 0) { p0 = __builtin_amdgcn_mfma_f32_32x32x16_bf16(b0, qr[0], negm, 0, 0, 0); p1 = __builtin_amdgcn_mfma_f32_32x32x16_bf16(b1, qr[0], negm, 0, 0, 0); }
    else { p0 = __builtin_amdgcn_mfma_f32_32x32x16_bf16(b0, qr[d0], p0, 0, 0, 0); p1 = __builtin_amdgcn_mfma_f32_32x32x16_bf16(b1, qr[d0], p1, 0, 0, 0); } }
}
__device__ __forceinline__ int v_st(int k, int c) { const int kk = k; return ((kk >> 3) * 2 + (c >> 5)) * 512 + ((kk & 7) * 32 + (c & 31)) * 2; }
__device__ __forceinline__ int v_rd_base(int lane) { return ((lane & 3) << 3) | (((lane >> 2) & 3) << 6) | (((lane >> 4) & 1) << 5) | (((lane >> 5) & 1) << 8); }
constexpr int v_rd_off(int d0, int ks, int half) { return d0 * 512 + ks * 2048 + half * 1024; }
template <int OFF> __device__ __forceinline__ s16x4 tr_read(int vb) {
  s16x4 r; asm volatile("ds_read_b64_tr_b16 %0, %1 offset:%2" : "=&v"(r) : "v"(vb), "i"(OFF) : "memory"); return r;
}
template <int D0> __device__ __forceinline__ void pv_one(f32x16& od, int vb, bf16x8 pa0, bf16x8 pa1, bf16x8 pa2, bf16x8 pa3) {
  const s16x4 l0 = tr_read<v_rd_off(D0, 0, 0)>(vb), h0 = tr_read<v_rd_off(D0, 0, 1)>(vb), l1 = tr_read<v_rd_off(D0, 1, 0)>(vb), h1 = tr_read<v_rd_off(D0, 1, 1)>(vb);
  const s16x4 l2 = tr_read<v_rd_off(D0, 2, 0)>(vb), h2 = tr_read<v_rd_off(D0, 2, 1)>(vb), l3 = tr_read<v_rd_off(D0, 3, 0)>(vb), h3 = tr_read<v_rd_off(D0, 3, 1)>(vb);
  asm volatile("s_waitcnt lgkmcnt(0)" ::: "memory"); SBAR();
#define PK(L, H) (bf16x8){L[0], L[1], L[2], L[3], H[0], H[1], H[2], H[3]}
  od = __builtin_amdgcn_mfma_f32_32x32x16_bf16(pa0, PK(l0, h0), od, 0, 0, 0);
  od = __builtin_amdgcn_mfma_f32_32x32x16_bf16(pa1, PK(l1, h1), od, 0, 0, 0);
  od = __builtin_amdgcn_mfma_f32_32x32x16_bf16(pa2, PK(l2, h2), od, 0, 0, 0);
  od = __builtin_amdgcn_mfma_f32_32x32x16_bf16(pa3, PK(l3, h3), od, 0, 0, 0);
#undef PK
}
__device__ __forceinline__ void pv_d0(f32x16* o, int vb, bf16x8 pa0, bf16x8 pa1, bf16x8 pa2, bf16x8 pa3) {
  pv_one<0>(o[0], vb, pa0, pa1, pa2, pa3); pv_one<1>(o[1], vb, pa0, pa1, pa2, pa3);
}
__device__ __forceinline__ void attn_unit(const bf16_t* __restrict__ Qb, const bf16_t* __restrict__ KVh, const bf16_t* __restrict__ KPEb, const f32x2* __restrict__ csq, bf16_t* __restrict__ Ob, char* lds) {
  const int tid = opaque_tid(), wid = tid >> 6, lane = tid & 63, r32 = lane & 31, hi = lane >> 5;
  char* V_lds = lds; char* K_lds = lds + NSLOT * SHM_V;
  float* ws = (float*)(lds + NSLOT * SHM_V + NSLOT * SHM_K) + wid * 64; float* li_l = ws; float* al_l = ws + 32;
  float m_reg = 0.f, l_reg = 0; f32x16 o[2] = {}; bf16x8 qr[6]; f32x16 negm = {};
  const bf16_t* Qw = Qb + (long)(wid * QBLK + r32) * 768 + hi * 8;
#pragma unroll
  for (int d0 = 0; d0 < 6; ++d0) qr[d0] = *reinterpret_cast<const bf16x8*>(Qw + d0 * 16);
#pragma unroll
  for (int d0 = 4; d0 < 6; ++d0) {
    const f32x2* c = csq + (wid * QBLK + r32) * 16 + 8 * (d0 - 4) + 4 * hi;
    float f[8], g[8]; unpack8(__builtin_bit_cast(u32x4, qr[d0]), f);
#pragma unroll
    for (int p = 0; p < 4; ++p) { const f32x2 cc = c[p]; g[2 * p] = f[2 * p] * cc.x - f[2 * p + 1] * cc.y; g[2 * p + 1] = f[2 * p] * cc.y + f[2 * p + 1] * cc.x; }
    qr[d0] = __builtin_bit_cast(bf16x8, pack8(g));
  }
  const int kc0 = tid, kc1 = 512 + (tid & 255);
  const int kd0 = KSWZ(kc0 / 12, (kc0 % 12) * 16), kd1 = KSWZ(kc1 / 12, (kc1 % 12) * 16), vd0 = v_st(tid >> 3, (tid & 7) * 8);
  const int cc0 = kc0 % 12, cc1 = kc1 % 12;
  const bf16_t* ksrc0 = cc0 < 8 ? KVh + (long)(kc0 / 12) * 1024 + cc0 * 8 : KPEb + (long)(kc0 / 12) * ROPE + (cc0 - 8) * 8;
  const bf16_t* ksrc1 = cc1 < 8 ? KVh + (long)(kc1 / 12) * 1024 + cc1 * 8 : KPEb + (long)(kc1 / 12) * ROPE + (cc1 - 8) * 8;
  const int kstr0 = cc0 < 8 ? 1024 : ROPE, kstr1 = cc1 < 8 ? 1024 : ROPE;
  const bf16_t* vsrc = KVh + 64 + (long)(tid >> 3) * 1024 + (tid & 7) * 8;
  const bool k1w = tid < 256;
  const int vb0 = (int)(uintptr_t)V_lds + v_rd_base(lane);
  struct { bf16x8 vs0, ks0, ks1; } sr_[2];
#define SLOAD(i, k0) do { sr_[i].vs0 = *reinterpret_cast<const bf16x8*>(vsrc + (long)(k0) * 1024); \
    sr_[i].ks0 = *reinterpret_cast<const bf16x8*>(ksrc0 + (long)(k0) * kstr0); sr_[i].ks1 = *reinterpret_cast<const bf16x8*>(ksrc1 + (long)(k0) * kstr1); } while (0)
#define SWRITE(b, i) do { *(bf16x8*)(V_lds + (b) * SHM_V + vd0) = sr_[i].vs0; *(bf16x8*)(K_lds + (b) * SHM_K + kd0) = sr_[i].ks0; \
    if (k1w) *(bf16x8*)(K_lds + (b) * SHM_K + kd1) = sr_[i].ks1; } while (0)
#define SWAIT() asm volatile("s_waitcnt vmcnt(3)" ::: "memory")
#define RESC(a) do { if (__any((a) < 1.f)) { if (hi == 0) al_l[r32] = (a); asm volatile("s_waitcnt lgkmcnt(0)" ::: "memory"); \
    _Pragma("unroll") for (int d = 0; d < 2; ++d) _Pragma("unroll") for (int r = 0; r < 16; ++r) o[d][r] *= al_l[crow(r, hi)]; } } while (0)
  f32x16 pA0, pA1, pB0, pB1; float alA, alB; bf16x8 pa0, pa1, pa2, pa3; constexpr int NT = SEQ / KVBLK;
  constexpr int SE = 0, SO = 1;
#define LBAR() asm volatile("s_waitcnt lgkmcnt(0)\n\ts_barrier" ::: "memory")
  SLOAD(SE, 0); asm volatile("s_waitcnt vmcnt(0)" ::: "memory"); SWRITE(0, SE); LBAR();
  qkt(pA0, pA1, K_lds, qr, negm, r32, hi); partialSM<true>(pA0, pA1, m_reg, negm, alA);
  SLOAD(SO, KVBLK); SLOAD(SE, 2 * KVBLK);
  SWAIT(); SWRITE(1, SO); LBAR();
  int s_prev = 0, s_cur = 1, s_next = 2;
#define ROT() do { s_prev = s_cur; s_cur = s_next; s_next = (s_next == NSLOT - 1) ? 0 : s_next + 1; } while (0)
  for (int j = 1; j + 1 < NT; j += 2) {
    SBAR(); qkt(pB0, pB1, K_lds + s_cur * SHM_K, qr, negm, r32, hi);
    finishSM(pA0, pA1, alA, l_reg, pa0, pa1, pa2, pa3); SBAR();
    SLOAD(SO, (j + 2) * KVBLK); SBAR();
    pv_d0(o, vb0 + s_prev * SHM_V, pa0, pa1, pa2, pa3); partialSM<false>(pB0, pB1, m_reg, negm, alB);
    SWAIT(); SWRITE(s_next, SE);
    RESC(alB); LBAR(); ROT();
    SBAR(); qkt(pA0, pA1, K_lds + s_cur * SHM_K, qr, negm, r32, hi);
    finishSM(pB0, pB1, alB, l_reg, pa0, pa1, pa2, pa3); SBAR();
    if (j + 3 < NT) SLOAD(SE, (j + 3) * KVBLK); SBAR();
    pv_d0(o, vb0 + s_prev * SHM_V, pa0, pa1, pa2, pa3); partialSM<false>(pA0, pA1, m_reg, negm, alA);
    SWAIT(); SWRITE(s_next, SO);
    RESC(alA); LBAR(); ROT();
  }
  SBAR(); qkt(pB0, pB1, K_lds + s_cur * SHM_K, qr, negm, r32, hi);
  finishSM(pA0, pA1, alA, l_reg, pa0, pa1, pa2, pa3); SBAR();
  pv_d0(o, vb0 + s_prev * SHM_V, pa0, pa1, pa2, pa3); partialSM<false>(pB0, pB1, m_reg, negm, alB);
  RESC(alB);
  finishSM(pB0, pB1, alB, l_reg, pa0, pa1, pa2, pa3); SBAR();
  pv_d0(o, vb0 + s_cur * SHM_V, pa0, pa1, pa2, pa3);
#undef ROT
#undef LBAR
  if (hi == 0) li_l[r32] = l_reg; asm volatile("s_waitcnt lgkmcnt(0)" ::: "memory");
  float rli[16];
#pragma unroll
  for (int r = 0; r < 16; ++r) rli[r] = __builtin_amdgcn_rcpf(li_l[crow(r, hi)]);
  bf16_t* Ow = Ob + (long)(wid * QBLK) * 1024;
#pragma unroll
  for (int r = 0; r < 16; ++r) { int orow = crow(r, hi);
#pragma unroll
    for (int d0 = 0; d0 < 2; ++d0) Ow[(long)orow * 1024 + d0 * 32 + r32] = (bf16_t)f2bf(o[d0][r] * rli[r]); }
  __syncthreads();
#undef SLOAD
#undef SWRITE
#undef SWAIT
#undef RESC
}
#undef SBAR
}

__device__ __forceinline__ void attn_phase(const Ctx& C, const bf16_t* Q, const bf16_t* KV, const bf16_t* KPE, const f32x2* cs, bf16_t* O) {
#if FAST_ATTN
    const int v = (C.nblk % 8 == 0) ? (C.blk % 8) * (C.nblk / 8) + C.blk / 8 : C.blk;
    for (int u = v; u < NB * NH * (SEQ / 256); u += C.nblk) {
        const int bh = u >> 3, qb = u & 7, b = bh >> 3, h = bh & 7;
        att::attn_unit(Q + ((size_t)b * SEQ + qb * 256) * 768 + h * DQK, KV + (size_t)b * SEQ * 1024 + h * 128, KPE + (size_t)b * SEQ * ROPE, cs + qb * 256 * 16,
                       O + ((size_t)b * SEQ + qb * 256) * 1024 + h * VH, (char*)C.lds);
    }
#else
    for (int it = C.blk; it < NB * NH * (SEQ / NTHR); it += C.nblk) {
        const int bh = it >> 2, q = (it & 3) * NTHR + C.tid, b = bh >> 3, h = bh & 7;
        float qv[DQK], o[VH];
        const bf16_t* qp = Q + ((size_t)b * SEQ + q) * 768 + h * DQK;
#pragma unroll
        for (int d = 0; d < DQK; d += 8) unpack8(*(const u32x4*)(qp + d), qv + d);
#pragma unroll
        for (int i = 0; i < 16; ++i) { const f32x2 cc = cs[q * 16 + i]; const float x0 = bf2f(f2bf(qv[64 + 2 * i])), x1 = qv[65 + 2 * i]; qv[64 + 2 * i] = x0 * cc.x - x1 * cc.y; qv[65 + 2 * i] = x0 * cc.y + x1 * cc.x; }
#pragma unroll
        for (int d = 0; d < VH; ++d) o[d] = 0.f;
        float m = -1e30f, l = 0.f;
        for (int k = 0; k < SEQ; ++k) {
            const bf16_t* kvp = KV + ((size_t)b * SEQ + k) * 1024 + h * 128; const bf16_t* pep = KPE + ((size_t)b * SEQ + k) * ROPE; const bf16_t* vp = kvp + 64;
            float s = 0.f;
#pragma unroll
            for (int d = 0; d < DQK; d += 8) { float kf[8]; unpack8(*(const u32x4*)(d < 64 ? kvp + d : pep + (d - 64)), kf);
#pragma unroll
                for (int e = 0; e < 8; ++e) s += qv[d + e] * kf[e]; }
            const float mn = fmaxf(m, s), al = exp2f(m - mn), p = exp2f(s - mn);
            l = l * al + p; m = mn;
#pragma unroll
            for (int d = 0; d < VH; d += 8) { float vf[8]; unpack8(*(const u32x4*)(vp + d), vf);
#pragma unroll
                for (int e = 0; e < 8; ++e) o[d + e] = o[d + e] * al + p * vf[e]; }
        }
        const float rl = 1.0f / l;
        bf16_t* op = O + ((size_t)b * SEQ + q) * 1024 + h * VH;
#pragma unroll
        for (int d = 0; d < VH; d += 8) { float t[8];
#pragma unroll
            for (int e = 0; e < 8; ++e) t[e] = o[d + e] * rl;
            *(u32x4*)(op + d) = pack8(t); }
    }
#endif
}

constexpr int HY_CS = 8256;
__device__ __forceinline__ void hyena_phase(const Ctx& C, const bf16_t* tapsR  , const bf16_t* zT, bf16_t* yT) {
#if FAST_HYENA
    const int lane = C.lane, r = lane & 31, h = lane >> 5, w = C.wave;
    const int kc = (7 - r) & 7;
    const int lane_base = kc * HY_CS + 2 * (2047 - r - kc + 32 * h);
    for (int c = C.blk; c < DHY; c += C.nblk) {
        __syncthreads();
        const bf16_t* R = tapsR + (size_t)c * 4096;
        for (int idx = C.tid; idx < 4096; idx += NTHR) { const unsigned short v = R[idx];
#pragma unroll
            for (int k = 0; k < 8; ++k) { const int m = idx - k; if (m >= 0) *(LAS unsigned short*)(C.lds + k * HY_CS + 2 * m) = v; } }
        __syncthreads();
        f32x16 acc[8];
#pragma unroll
        for (int i = 0; i < 8; ++i) acc[i] = f32x16{};
        const bf16_t* zrow = zT + ((size_t)c * NB + r) * SEQ + 32 * h;
        bf16x8 zf[4], zn[4];
#pragma unroll
        for (int k = 0; k < 4; ++k) zf[k] = *(const bf16x8*)(zrow + 8 * k);
        for (int S0 = 0; S0 < SEQ; S0 += 64) {
            const int S1 = (S0 + 64 < SEQ) ? S0 + 64 : S0;
#pragma unroll
            for (int k = 0; k < 4; ++k) zn[k] = *(const bf16x8*)(zrow + S1 + 8 * k);
            const LAS unsigned char* tb = C.lds + (lane_base + 2 * (S0 - 256 * w - 224));
#pragma unroll
            for (int k = 0; k < 4; ++k)
#pragma unroll
                for (int i = 0; i < 8; ++i) {
                    const bf16x8 tf = *(const LAS bf16x8*)(tb + 64 * (7 - i) + 16 * k);
                    acc[i] = __builtin_amdgcn_mfma_f32_32x32x16_bf16(zf[k], tf, acc[i], 0, 0, 0);
                }
#pragma unroll
            for (int k = 0; k < 4; ++k) zf[k] = zn[k];
        }
#pragma unroll
        for (int i = 0; i < 8; ++i)
#pragma unroll
            for (int q = 0; q < 16; ++q) { const int b = (q & 3) + 8 * (q >> 2) + 4 * h;
                yT[((size_t)c * NB + b) * SEQ + 256 * w + 32 * i + r] = (bf16_t)f2bf(acc[i][q]); }
    }
#else
    LAS float* Rf = (LAS float*)C.lds; LAS float* zf = (LAS float*)(C.lds + 16384);
    for (int it = C.blk; it < DHY * NB; it += C.nblk) {
        const int c = it >> 5, b = it & 31;
        __syncthreads();
        for (int i = C.tid; i < 4096; i += NTHR) Rf[i] = bf2f(tapsR[(size_t)c * 4096 + i]);
        for (int i = C.tid; i < SEQ; i += NTHR) zf[i] = bf2f(zT[((size_t)c * NB + b) * SEQ + i]);
        __syncthreads();
        float y[4] = {0.f, 0.f, 0.f, 0.f};
        for (int s = 0; s < SEQ; ++s) { const float z = zf[s];
#pragma unroll
            for (int k = 0; k < 4; ++k) y[k] += Rf[2047 - (C.tid + NTHR * k) + s] * z; }
#pragma unroll
        for (int k = 0; k < 4; ++k) yT[((size_t)c * NB + b) * SEQ + C.tid + NTHR * k] = (bf16_t)f2bf(y[k]);
    }
#endif
}

__global__ void __launch_bounds__(NTHR) mega_fwd(Params P) {
    extern __shared__ __attribute__((aligned(16))) unsigned char lds_raw[];
    cg::grid_group grid = cg::this_grid();
    Ctx C; C.tid = threadIdx.x; C.lane = C.tid & 63; C.wave = __builtin_amdgcn_readfirstlane(C.tid >> 6); C.blk = blockIdx.x; C.nblk = gridDim.x;
    C.lds = (LAS unsigned char*)lds_raw;
    unsigned char* ws = P.ws;
    bf16_t* Hb = (bf16_t*)(ws + WS_H); bf16_t* LAT = (bf16_t*)(ws + WS_LAT); bf16_t* HYIN = (bf16_t*)(ws + WS_HYIN); unsigned char* GATES = (unsigned char*)(ws + WS_GATES);
    bf16_t* Qb = (bf16_t*)(ws + WS_Q); bf16_t* KVb = (bf16_t*)(ws + WS_KV); bf16_t* KPE = (bf16_t*)(ws + WS_KPE); bf16_t* Ob = (bf16_t*)(ws + WS_O);
    bf16_t* ZT = (bf16_t*)(ws + WS_ZT); bf16_t* X0C = (bf16_t*)(ws + WS_X0C); bf16_t* YT = (bf16_t*)(ws + WS_YT);
    bf16_t* MERGED = (bf16_t*)(ws + WS_MERGED); bf16_t* ACT = (bf16_t*)(ws + WS_ACT);
    const f32x2* CS = (const f32x2*)(ws + WS_ROPE); float* SSQ = (float*)(ws + WS_SSQ);
    float* out = P.out;
#define XB ((bf16_t*)P.out)

#define PH_BEGIN() do { C.tid = opaque_tid(); C.lane = C.tid & 63; C.wave = __builtin_amdgcn_readfirstlane(C.tid >> 6); } while (0)
    volatile LAS unsigned* bst = (volatile LAS unsigned*)(C.lds + LDS_CTL);
    if (C.tid < 4) bst[C.tid] = 0u;
    if (C.blk == 0) for (int i = C.tid; i < XCD_BAR_WORDS; i += NTHR) ((unsigned*)(ws + WS_BAR))[i] = 0u;
    __syncthreads();
    XcdBarrier xbar; bool xposted = false;
#define GRID_SYNC() do { if (!xposted) { grid.sync(); xbar = xcd_barrier_post((unsigned*)(ws + WS_BAR), bst); xposted = true; } else xcd_barrier(xbar); } while (0)
    for (int rep = 0; rep < (DBL_PHASE == 7 ? 2 : 1); ++rep) prologue(P, C);
    for (int l = 0; l < 2; ++l) {
        const unsigned char* wl = ws + WS_W + (size_t)l * W_LAYER;
        const bf16_t* WinT = (const bf16_t*)(wl + WO_IN); const bf16_t* WqT = (const bf16_t*)(wl + WO_Q); const bf16_t* WkvT = (const bf16_t*)(wl + WO_KV);
        const bf16_t* WaT = (const bf16_t*)(wl + WO_A); const bf16_t* WhT = (const bf16_t*)(wl + WO_H); const bf16_t* WoT = (const bf16_t*)(wl + WO_O);
        const bf16_t* WguT = (const bf16_t*)(wl + WO_GU); const bf16_t* WdT = (const bf16_t*)(wl + WO_D);
        const float* xin = l == 0 ? P.in[0] : out;
        if (l == 0) { xcast_rows(C, P.in[0], XB, SSQ); GRID_SYNC(); PH_BEGIN(); }
        for (int rep = 0; rep < (DBL_PHASE == 3 ? 2 : 1); ++rep) run_gemm<true>(C, XB, DM, WinT, 4096, DM, FInProj{LAT, HYIN, GATES, SSQ + (size_t)(2 * l) * MTOK * 4});
        GRID_SYNC(); PH_BEGIN();
        for (int rep = 0; rep < (DBL_PHASE == 5 ? 2 : 1); ++rep) {
        lat_rows(C, LAT, CS, KPE);
        PH_BEGIN();
        hy_pre(C, HYIN, P.in[9] + l * 3 * 1536, P.in[10] + l * 1536, X0C, ZT); }
        GRID_SYNC(); PH_BEGIN();
        for (int rep = 0; rep < (DBL_PHASE == 6 ? 2 : 1); ++rep) {
        run_gemm<true>(C, LAT, 512, WqT, 768, 256, FPlain{Qb, 768});
        PH_BEGIN();
        run_gemm<true>(C, LAT + 256, 512, WkvT, 1024, 256, FPlain{KVb, 1024}); }
        GRID_SYNC(); PH_BEGIN();
        for (int rep = 0; rep < (DBL_PHASE == 1 ? 2 : 1); ++rep) hyena_phase(C, (const bf16_t*)(ws + WS_TAPS) + (size_t)l * DHY * 4096, ZT, YT);
        __syncthreads(); PH_BEGIN();
        for (int rep = 0; rep < (DBL_PHASE == 2 ? 2 : 1); ++rep) attn_phase(C, Qb, KVb, KPE, CS, Ob);
        GRID_SYNC(); PH_BEGIN();
        hy_post(C, YT, X0C, Ob);
        GRID_SYNC(); PH_BEGIN();
        run_gemm_epi(C, Ob, 1024, (const bf16_t*)(ws + WS_WM + (size_t)l * WM_LAYER), 2048, 1024, EpiMerge2{GATES, MERGED});
        GRID_SYNC(); PH_BEGIN();
        run_gemm_epi(C, MERGED, DM, WoT, DM, DM, EpiResidB{XB, SSQ + (size_t)(2 * l + 1) * MTOK * 4, (LAS float*)(C.lds + LDS_TAB)});
        GRID_SYNC(); PH_BEGIN();
        for (int rep = 0; rep < (DBL_PHASE == 4 ? 2 : 1); ++rep) run_gemm<true>(C, XB, DM, WguT, 2 * DFF, DM, FSwiglu{ACT, SSQ + (size_t)(2 * l + 1) * MTOK * 4});
        GRID_SYNC(); PH_BEGIN();
        if (l == 0) run_gemm_epi(C, ACT, DFF, WdT, DM, DFF, EpiResidB{XB, SSQ + (size_t)2 * MTOK * 4, (LAS float*)(C.lds + LDS_TAB)});
        else run_gemm_epi(C, ACT, DFF, WdT, DM, DFF, EpiResidF{XB, (bf16_t*)(ws + WS_XF)});
        GRID_SYNC(); PH_BEGIN();
    }
    if (DBL_PHASE == 9) { for (int rep = 0; rep < 20; ++rep) GRID_SYNC(); }
    rmsnorm_final(C, (const bf16_t*)(ws + WS_XF), out, P.in[28]);
}

extern "C" void kernel_launch(void* const* d_in, const int* in_sizes, int n_in, void* d_out, int out_size, void* d_ws, size_t ws_size, hipStream_t stream) {
    static int grid = 0;
    if (grid == 0) {
        if (n_in != 29 || out_size != MTOK * DM || ws_size < WS_END) { fprintf(stderr, "kernel_launch: unexpected shapes (n_in %d out %d ws %zu)\n", n_in, out_size, ws_size); grid = -1; return; }
        int dev = 0, cus = 0, per_cu = 0;
        (void)hipGetDevice(&dev); (void)hipDeviceGetAttribute(&cus, hipDeviceAttributeMultiprocessorCount, dev);
        if (hipFuncSetAttribute((const void*)mega_fwd, hipFuncAttributeMaxDynamicSharedMemorySize, LDS_BYTES) != hipSuccess) { fprintf(stderr, "kernel_launch: hipFuncSetAttribute failed\n"); }
        if (hipOccupancyMaxActiveBlocksPerMultiprocessor(&per_cu, (const void*)mega_fwd, NTHR, LDS_BYTES) != hipSuccess || per_cu < 1) { fprintf(stderr, "kernel_launch: occupancy query says %d\n", per_cu); per_cu = 1; }
        (void)hipGetLastError();
        grid = cus > 0 ? cus : 256;
    }
    if (grid < 0) return;
    Params p{};
    for (int i = 0; i < 29; ++i) p.in[i] = (const float*)d_in[i];
    p.out = (float*)d_out; p.ws = (unsigned char*)d_ws;
    void* args[] = {&p};
    hipError_t e = hipLaunchCooperativeKernel((const void*)mega_fwd, dim3(grid), dim3(NTHR), args, LDS_BYTES, stream);
    if (e != hipSuccess) fprintf(stderr, "kernel_launch: cooperative launch failed: %s (grid %d)\n", hipGetErrorString(e), grid);
}
```
